# Optimizing an MI355X kernel written in HIP

```python
import jax, jax.numpy as jnp
from jax import lax
import numpy as np

D_MODEL = 2048
BATCH = 1
SEQ = 16384
DEPTH = 2

GRID_W = 64
CTX_LEN = 256
HEAD_DIM = 128
N_ATT_HEADS = 8
N_KV_HEADS = 2
N_RET_HEADS = 8
ATT_W = N_ATT_HEADS * HEAD_DIM
KV_W = N_KV_HEADS * HEAD_DIM
RET_W = N_RET_HEADS * HEAD_DIM
MIX_W = ATT_W + RET_W
IN_COLS = ATT_W + 2 * KV_W + 4 * RET_W
WINDOW = 128
BLOCK = 128
RET_CHUNK = 128
ROPE_THETA = 10000.0
ROPE_PAIRS = HEAD_DIM // 4
D_FF = 256 * ((8 * D_MODEL // 3 + 255) // 256)
N_EXPERTS = 8
TOP_K = 2
D_FF_EXPERT = D_FF
N_DENSE = (DEPTH + 1) // 2
N_MOE = DEPTH // 2
EPS = 1e-6

kernel_name = "hymba_style_swa_retention_moe_dit_trunk"


def rmsnorm(x, g):
    x32 = x.astype(jnp.float32)
    y = x32 * lax.rsqrt(jnp.mean(x32 * x32, axis=-1, keepdims=True) + EPS)
    return (y * g.astype(jnp.float32)).astype(x.dtype)


def modulate(h, shift, scale):
    return h * (1 + scale) + shift


def axial_rope_tables(n_rows):
    row = jnp.repeat(jnp.arange(n_rows), GRID_W)
    col = jnp.tile(jnp.arange(GRID_W), n_rows)
    inv = ROPE_THETA ** (-jnp.arange(ROPE_PAIRS, dtype=jnp.float32) / ROPE_PAIRS)
    ang = jnp.stack([row, col], axis=-1).astype(jnp.float32)[:, :, None] * inv
    return jnp.cos(ang), jnp.sin(ang)


def apply_axial_rope(x, cos, sin):
    shp = x.shape
    xr = x.astype(jnp.float32).reshape(*shp[:-1], 2, 2, ROPE_PAIRS)
    x1, x2 = xr[..., 0, :], xr[..., 1, :]
    cs, sn = cos[None, :, None], sin[None, :, None]
    out = jnp.stack([x1 * cs - x2 * sn, x2 * cs + x1 * sn], axis=-2)
    return out.reshape(shp).astype(x.dtype)


def split_projection(p):
    cuts = np.cumsum([ATT_W, KV_W, KV_W, RET_W, RET_W, RET_W])
    return jnp.split(p, [int(v) for v in cuts], axis=-1)


def attention_heads(qa, ka, va, qg, kg):
    B, N, _ = qa.shape
    q = rmsnorm(qa.reshape(B, N, N_ATT_HEADS, HEAD_DIM), qg)
    k = rmsnorm(ka.reshape(B, N, N_KV_HEADS, HEAD_DIM), kg)
    v = va.reshape(B, N, N_KV_HEADS, HEAD_DIM)
    return q, k, v


def sink_column(sink, shape_prefix):
    g = N_ATT_HEADS // N_KV_HEADS
    s = sink.astype(jnp.float32).reshape(N_KV_HEADS, g)
    return jnp.broadcast_to(s.reshape((1,) * (len(shape_prefix) - 3) + (N_KV_HEADS, g, 1, 1)), shape_prefix + (1,))


def windowed_attention(q, k, v, k_ctx, v_ctx, sink):
    B, S, H, d = q.shape
    G = H // N_KV_HEADS
    nb = S // BLOCK
    scale = d ** -0.5
    qb = q.reshape(B, nb, BLOCK, N_KV_HEADS, G, d)
    pad = ((0, 0), (BLOCK, BLOCK), (0, 0), (0, 0))
    kp = jnp.pad(k, pad).reshape(B, nb + 2, BLOCK, N_KV_HEADS, d)
    vp = jnp.pad(v, pad).reshape(B, nb + 2, BLOCK, N_KV_HEADS, d)
    kb = jnp.concatenate([kp[:, :-2], kp[:, 1:-1], kp[:, 2:]], axis=2)
    vb = jnp.concatenate([vp[:, :-2], vp[:, 1:-1], vp[:, 2:]], axis=2)
    s_loc = jnp.einsum('bnqhgd,bnjhd->bnhgqj', qb, kb).astype(jnp.float32) * scale
    qi = jnp.arange(nb)[:, None, None] * BLOCK + jnp.arange(BLOCK)[None, :, None]
    kj = jnp.arange(nb)[:, None, None] * BLOCK - BLOCK + jnp.arange(3 * BLOCK)[None, None, :]
    valid = (jnp.abs(qi - kj) <= WINDOW) & (kj >= 0) & (kj < S)
    s_loc = jnp.where(valid[None, :, None, None], s_loc, -jnp.inf)
    s_ctx = jnp.einsum('bnqhgd,bchd->bnhgqc', qb, k_ctx).astype(jnp.float32) * scale
    C = k_ctx.shape[1]
    scores = jnp.concatenate([sink_column(sink, s_ctx.shape[:-1]), s_ctx, s_loc], axis=-1)
    p = jax.nn.softmax(scores, axis=-1).astype(v.dtype)
    o = (jnp.einsum('bnhgqc,bchd->bnqhgd', p[..., 1:1 + C], v_ctx)
         + jnp.einsum('bnhgqj,bnjhd->bnqhgd', p[..., 1 + C:], vb))
    return o.reshape(B, S, H * d)


def context_attention(q, k, v, sink):
    B, C, H, d = q.shape
    G = H // N_KV_HEADS
    qg = q.reshape(B, C, N_KV_HEADS, G, d)
    s = jnp.einsum('bqhgd,bchd->bhgqc', qg, k).astype(jnp.float32) * (d ** -0.5)
    s = jnp.concatenate([sink_column(sink, s.shape[:-1]), s], axis=-1)
    p = jax.nn.softmax(s, axis=-1)[..., 1:].astype(v.dtype)
    return jnp.einsum('bhgqc,bchd->bqhgd', p, v).reshape(B, C, H * d)


def retention_heads(qr, kr, vr):
    B, N, _ = qr.shape
    sh = (B, N, N_RET_HEADS, HEAD_DIM)
    return qr.reshape(sh), kr.reshape(sh), vr.reshape(sh)


def to_bhnd(t):
    return jnp.transpose(t, (0, 2, 1, 3)).astype(jnp.float32)


def retention_context(q, k, v, log_g):
    C = q.shape[2]
    pos = jnp.arange(C, dtype=jnp.float32)
    rel = pos[:, None] - pos[None, :]
    d_f = jnp.where(rel >= 0, jnp.exp(jnp.maximum(rel, 0.0)[None] * log_g[0][:, None, None]), 0.0)
    d_b = jnp.where(rel <= 0, jnp.exp(jnp.maximum(-rel, 0.0)[None] * log_g[1][:, None, None]), 0.0)
    s = jnp.einsum('bhnd,bhmd->bhnm', q, k) * (d_f + d_b)[None]
    return jnp.einsum('bhnm,bhme->bhne', s, v)


def retention_context_states(k, v, log_g):
    C = k.shape[2]
    pos = jnp.arange(C, dtype=jnp.float32)
    w_f = jnp.exp((C - 1 - pos)[None] * log_g[0][:, None])
    w_b = jnp.exp(pos[None] * log_g[1][:, None])
    s_f = jnp.einsum('bhmd,bhme->bhde', k * w_f[None, :, :, None], v)
    s_b = jnp.einsum('bhmd,bhme->bhde', k * w_b[None, :, :, None], v)
    return s_f, s_b


def retention_chunkwise(q, k, v, log_g, s0):
    B, H, L, d = q.shape
    nz = L // RET_CHUNK
    qc = q.reshape(B, H, nz, RET_CHUNK, d)
    kc = k.reshape(B, H, nz, RET_CHUNK, d)
    vc = v.reshape(B, H, nz, RET_CHUNK, d)
    pos = jnp.arange(RET_CHUNK, dtype=jnp.float32)
    lg = log_g[:, None]
    rel = pos[:, None] - pos[None, :]
    decay_in = jnp.where(rel >= 0, jnp.exp(jnp.maximum(rel, 0.0)[None] * lg[:, :, None]), 0.0)
    q_dec = jnp.exp((pos + 1.0)[None] * lg)
    k_dec = jnp.exp((RET_CHUNK - 1.0 - pos)[None] * lg)
    chunk_decay = jnp.exp(RET_CHUNK * log_g)
    s = jnp.einsum('bhzid,bhzjd->bhzij', qc, kc) * decay_in[None, :, None]
    inner = jnp.einsum('bhzij,bhzje->bhzie', s, vc)
    kv = jnp.einsum('bhzjd,bhzje->zbhde', kc * k_dec[None, :, None, :, None], vc)

    def step(state, kv_z):
        return chunk_decay[None, :, None, None] * state + kv_z, state

    _, s_prev = lax.scan(step, s0, kv)
    cross = jnp.einsum('bhzid,zbhde->bhzie', qc * q_dec[None, :, None, :, None], s_prev)
    return (inner + cross).reshape(B, H, L, d)


def retention_output(y, gate, gn_g):
    B, H, N, d = y.shape
    mu = jnp.mean(y, axis=-1, keepdims=True)
    var = jnp.mean(jnp.square(y - mu), axis=-1, keepdims=True)
    yn = (y - mu) * lax.rsqrt(var + EPS) * gn_g.astype(jnp.float32)[None, :, None, :]
    yn = jnp.transpose(yn, (0, 2, 1, 3)).reshape(B, N, H * d).astype(gate.dtype)
    return jax.nn.silu(gate) * yn


def swiglu(h, w1, w3, w2):
    return (jax.nn.silu(h @ w1) * (h @ w3)) @ w2


def moe_swiglu(h, router_w, router_b, w1, w3, w2):
    logits = (h @ router_w + router_b).astype(jnp.float32)
    top_val, top_idx = lax.top_k(logits, TOP_K)
    top_w = jax.nn.softmax(top_val, axis=-1)
    gates = jnp.sum(jax.nn.one_hot(top_idx, N_EXPERTS, dtype=jnp.float32) * top_w[..., None], axis=-2)
    y = jnp.zeros_like(h)
    for e in range(N_EXPERTS):
        y = y + gates[..., e:e + 1].astype(h.dtype) * swiglu(h, w1[e], w3[e], w2[e])
    return y


def channel_mixer(i, h, ffn_w1, ffn_w3, ffn_w2, router_w, router_b, moe_w1, moe_w3, moe_w2):
    j = i // 2
    if i % 2 == 0:
        return swiglu(h, ffn_w1[j], ffn_w3[j], ffn_w2[j])
    return moe_swiglu(h, router_w[j], router_b[j], moe_w1[j], moe_w3[j], moe_w2[j])


def setup_inputs(seed: int = 0) -> dict:
    key = jax.random.key(seed)
    ks = jax.random.split(key, 24)
    f32 = jnp.float32
    nrm = lambda k, shape, s: jax.random.normal(k, shape, f32) * s
    a = 5.0 + jnp.arange(N_RET_HEADS, dtype=f32)
    decay_logit = jnp.log(2.0 ** a - 1.0)
    return {
        "x": nrm(ks[0], (BATCH, SEQ, D_MODEL), 1.0),
        "c": nrm(ks[1], (BATCH, D_MODEL), 1.0),
        "ctx": nrm(ks[2], (BATCH, CTX_LEN, D_MODEL), 1.0),
        "c_ctx": nrm(ks[3], (D_MODEL,), 1.0),
        "ada_w": nrm(ks[4], (DEPTH, D_MODEL, 6 * D_MODEL), 0.5 * D_MODEL ** -0.5),
        "ada_b": nrm(ks[5], (DEPTH, 6 * D_MODEL), 0.01),
        "norm1_g": 1.0 + nrm(ks[6], (DEPTH, D_MODEL), 0.02),
        "norm2_g": 1.0 + nrm(ks[7], (DEPTH, D_MODEL), 0.02),
        "w_in": nrm(ks[8], (DEPTH, D_MODEL, IN_COLS), D_MODEL ** -0.5),
        "q_norm_g": 1.0 + nrm(ks[9], (DEPTH, HEAD_DIM), 0.02),
        "k_norm_g": 1.0 + nrm(ks[10], (DEPTH, HEAD_DIM), 0.02),
        "attn_sink": nrm(ks[11], (DEPTH, N_ATT_HEADS), 0.5),
        "ret_decay": decay_logit[None, None, :] + nrm(ks[12], (DEPTH, 2, N_RET_HEADS), 0.1),
        "ret_gn_g": 1.0 + nrm(ks[13], (DEPTH, N_RET_HEADS, HEAD_DIM), 0.02),
        "w_out": nrm(ks[14], (DEPTH, MIX_W, D_MODEL), MIX_W ** -0.5),
        "ffn_w1": nrm(ks[15], (N_DENSE, D_MODEL, D_FF), D_MODEL ** -0.5),
        "ffn_w3": nrm(ks[16], (N_DENSE, D_MODEL, D_FF), D_MODEL ** -0.5),
        "ffn_w2": nrm(ks[17], (N_DENSE, D_FF, D_MODEL), D_FF ** -0.5),
        "router_w": nrm(ks[18], (N_MOE, D_MODEL, N_EXPERTS), D_MODEL ** -0.5),
        "router_b": nrm(ks[19], (N_MOE, N_EXPERTS), 0.01),
        "moe_w1": nrm(ks[20], (N_MOE, N_EXPERTS, D_MODEL, D_FF_EXPERT), D_MODEL ** -0.5),
        "moe_w3": nrm(ks[21], (N_MOE, N_EXPERTS, D_MODEL, D_FF_EXPERT), D_MODEL ** -0.5),
        "moe_w2": nrm(ks[22], (N_MOE, N_EXPERTS, D_FF_EXPERT, D_MODEL), D_FF_EXPERT ** -0.5),
    }


def reference(x, c, ctx, c_ctx, ada_w, ada_b, norm1_g, norm2_g, w_in, q_norm_g, k_norm_g,
              attn_sink, ret_decay, ret_gn_g, w_out, ffn_w1, ffn_w3, ffn_w2,
              router_w, router_b, moe_w1, moe_w3, moe_w2):
    B, S, _ = x.shape
    n_rows = S // GRID_W
    cos, sin = axial_rope_tables(n_rows)
    k_scale = HEAD_DIM ** -0.5
    x_lat, x_ctx = x, ctx
    for i in range(DEPTH):
        last = i == DEPTH - 1
        mod_l = jnp.split((jax.nn.silu(c) @ ada_w[i] + ada_b[i])[:, None, :], 6, axis=-1)
        mod_c = jnp.split(jax.nn.silu(c_ctx) @ ada_w[i] + ada_b[i], 6, axis=-1)
        log_g = jax.nn.log_sigmoid(ret_decay[i].astype(jnp.float32))

        h_l = modulate(rmsnorm(x_lat, norm1_g[i]), mod_l[0], mod_l[1])
        h_c = modulate(rmsnorm(x_ctx, norm1_g[i]), mod_c[0], mod_c[1])
        qa_l, ka_l, va_l, qr_l, kr_l, vr_l, gr_l = split_projection(h_l @ w_in[i])
        qa_c, ka_c, va_c, qr_c, kr_c, vr_c, gr_c = split_projection(h_c @ w_in[i])

        q_l, k_l, v_l = attention_heads(qa_l, ka_l, va_l, q_norm_g[i], k_norm_g[i])
        q_l = apply_axial_rope(q_l, cos, sin)
        k_l = apply_axial_rope(k_l, cos, sin)
        q_c, k_c, v_c = attention_heads(qa_c, ka_c, va_c, q_norm_g[i], k_norm_g[i])
        att_l = windowed_attention(q_l, k_l, v_l, k_c, v_c, attn_sink[i])

        rq_l, rk_l, rv_l = retention_heads(qr_l, kr_l, vr_l)
        rq_l = to_bhnd(apply_axial_rope(rq_l, cos, sin))
        rk_l = to_bhnd(apply_axial_rope(rk_l, cos, sin)) * k_scale
        rv_l = to_bhnd(rv_l)
        rq_c, rk_c, rv_c = retention_heads(qr_c, kr_c, vr_c)
        rq_c, rk_c, rv_c = to_bhnd(rq_c), to_bhnd(rk_c) * k_scale, to_bhnd(rv_c)
        s_f, s_b = retention_context_states(rk_c, rv_c, log_g)
        y_f = retention_chunkwise(rq_l, rk_l, rv_l, log_g[0], s_f)
        y_b = retention_chunkwise(rq_l[:, :, ::-1], rk_l[:, :, ::-1], rv_l[:, :, ::-1], log_g[1], s_b)[:, :, ::-1]
        ret_l = retention_output(y_f + y_b, gr_l, ret_gn_g[i])

        x_lat = x_lat + mod_l[2] * (jnp.concatenate([att_l, ret_l], axis=-1) @ w_out[i])

        h2_l = modulate(rmsnorm(x_lat, norm2_g[i]), mod_l[3], mod_l[4])
        x_lat = x_lat + mod_l[5] * channel_mixer(i, h2_l, ffn_w1, ffn_w3, ffn_w2,
                                                 router_w, router_b, moe_w1, moe_w3, moe_w2)

        if not last:
            att_c = context_attention(q_c, k_c, v_c, attn_sink[i])
            ret_c = retention_output(retention_context(rq_c, rk_c, rv_c, log_g), gr_c, ret_gn_g[i])
            x_ctx = x_ctx + mod_c[2] * (jnp.concatenate([att_c, ret_c], axis=-1) @ w_out[i])
            h2_c = modulate(rmsnorm(x_ctx, norm2_g[i]), mod_c[3], mod_c[4])
            x_ctx = x_ctx + mod_c[5] * channel_mixer(i, h2_c, ffn_w1, ffn_w3, ffn_w2,
                                                     router_w, router_b, moe_w1, moe_w3, moe_w2)
    return x_lat
```

```cpp
#include <hip/hip_runtime.h>
#include <cstdio>
#include <cstdint>
namespace pg8 {
#define PG8_LAS __attribute__((address_space(3)))
typedef unsigned short bf16_t;
typedef short bf16x8 __attribute__((ext_vector_type(8)));
typedef float f32x4 __attribute__((ext_vector_type(4)));
typedef unsigned u32x4 __attribute__((ext_vector_type(4)));
typedef int i32x4 __attribute__((ext_vector_type(4)));
typedef int i32x8 __attribute__((ext_vector_type(8)));
constexpr int BM = 256, BK = 64, HALF = 128, HTB = HALF * BK * 2  , STAGE_BYTES = 8 * HTB, NXCD = 8, WGM = 8;

__host__ __device__ __forceinline__ int lds_byte(int r, int c) { const int st = (r >> 4) * 2 + (c >> 5), rr = r & 15, cc = c & 31, ob = rr * 64 + cc * 2; return st * 1024 + (ob ^ (((ob >> 9) & 1) << 5)); }
__host__ __device__ __forceinline__ void stage_rc(int b, int& R, int& C) { const int st = b / 1024, sb = b % 1024, swz = sb ^ (((sb >> 9) & 1) << 5); R = (st >> 1) * 16 + swz / 64; C = (st & 1) * 32 + (swz % 64) / 2; }
__host__ __device__ __forceinline__ int perm32(int rho) { const int n = rho >> 4, i = rho & 15; return 8 * (i >> 2) + 4 * n + (i & 3); }

struct Unit { int pm, pn, ko, kt; };
struct Gemm { const bf16_t* A; const bf16_t* Bt; int M, N, K, ld; };

struct StaticOrder {
    static constexpr bool GATHER = false, VARK = false;
    int nM, nN, nwg, G, c;
    __host__ __device__ void init(int M, int N, int G_, int c_) { nM = M / BM; nN = N / BM; nwg = nM * nN; G = G_; c = c_; }
    __host__ __device__ bool next(int i, Unit& u) const {
        const long L = (long)i * G + c; if (L >= nwg) return false;
        int wgid = (int)L; { const int q = nwg / NXCD, r = nwg % NXCD, xcd = wgid % NXCD, off = wgid / NXCD; wgid = (xcd < r ? xcd * (q + 1) : r * (q + 1) + (xcd - r) * q) + off; }
        const int nig = WGM * nN, gid = wgid / nig, fm = gid * WGM, gsz = (nM - fm) < WGM ? (nM - fm) : WGM;
        u.pm = fm + ((wgid % nig) % gsz); u.pn = (wgid % nig) / gsz; u.ko = 0; return true;
    }
    __device__ __forceinline__ void a_ready(const Unit&) const {}
    __device__ __forceinline__ void done(const Unit&) const {}
};


__device__ __forceinline__ unsigned cvt_pk_bf16(float lo, float hi) { unsigned r; asm volatile("v_cvt_pk_bf16_f32 %0, %1, %2" : "=v"(r) : "v"(lo), "v"(hi)); return r; }
__device__ __forceinline__ float f8_scale(unsigned amax_bits) { const int ex = (int)((amax_bits >> 23) & 0xffu); if (ex == 0 || ex == 255) return 1.f;
    int se = 127 + 5 - (ex - 127); se = se < 1 ? 1 : (se > 254 ? 254 : se); return __uint_as_float((unsigned)se << 23); }
__device__ __forceinline__ unsigned pk4_fp8(float a, float b, float c, float d) {
    a = fminf(fmaxf(a, -448.f), 448.f); b = fminf(fmaxf(b, -448.f), 448.f); c = fminf(fmaxf(c, -448.f), 448.f); d = fminf(fmaxf(d, -448.f), 448.f);
    int w = __builtin_amdgcn_cvt_pk_fp8_f32(a, b, 0, false); w = __builtin_amdgcn_cvt_pk_fp8_f32(c, d, w, true); return (unsigned)w; }

__host__ __device__ __forceinline__ void moe_unit(long L, int P, int nN, int& pm, int& pn) {
    const int nwg = P * nN; int wgid = (int)L; { const int q = nwg / NXCD, r = nwg % NXCD, xcd = wgid % NXCD, off = wgid / NXCD; wgid = (xcd < r ? xcd * (q + 1) : r * (q + 1) + (xcd - r) * q) + off; }
    const int nig = WGM * nN, gid = wgid / nig, fm = gid * WGM, gsz = (P - fm) < WGM ? (P - fm) : WGM;
    pm = fm + ((wgid % nig) % gsz); pn = (wgid % nig) / gsz;
}
__host__ __device__ __forceinline__ int moe_index(int pm, int pn, int P, int nN) {
    const int nwg = P * nN, nig = WGM * nN, gid = pm / WGM, fm = gid * WGM, gsz = (P - fm) < WGM ? (P - fm) : WGM; const int wgid = gid * nig + pn * gsz + (pm - fm);
    const int q = nwg / NXCD, r = nwg % NXCD; int xcd, off; if (wgid < r * (q + 1)) { xcd = wgid / (q + 1); off = wgid % (q + 1); } else { const int t2 = wgid - r * (q + 1); xcd = r + t2 / q; off = t2 % q; }
    return off * NXCD + xcd;
}
struct MoeOrder {
    static constexpr bool GATHER = false, VARK = false;
    const PG8_LAS int* tab; int nN, G, c; int full_only;
    __device__ __forceinline__ bool next(int i, Unit& u) const {
        const int P = tab[0]; const long L = (long)i * G + c; const long U = (long)P * nN, lim = full_only ? (U / G) * G : U; if (L >= lim) return false;
        int pm, pn; moe_unit(L, P, nN, pm, pn); u.pm = pm; u.pn = tab[1 + pm] * nN + pn; u.ko = 0; return true;
    }
    __device__ __forceinline__ void a_ready(const Unit&) const {}
    __device__ __forceinline__ void done(const Unit&) const {}
};

struct MoeOrderE {
    static constexpr bool GATHER = true, VARK = false;
    const PG8_LAS int* tab; int nN, G, c; const int* slot_tok;
    __device__ __forceinline__ int arow(const Unit& u, int r) const { const int t = slot_tok[u.pm * BM + r]; return t < 0 ? 0 : t; }
    __device__ __forceinline__ bool next(int i, Unit& u) const {
        long L = (long)i * G + c; int e = 0, p0 = 0, np = 0;
        for (; e < 8; ++e) { p0 = tab[160 + e]; np = tab[161 + e] - p0; const long ue = (long)np * nN; if (L < ue) break; L -= ue; }
        if (e >= 8) return false;
        int pm, pn; moe_unit(L, np, nN, pm, pn); u.pm = p0 + pm; u.pn = e * nN + pn; u.ko = 0; return true;
    }
    __device__ __forceinline__ void a_ready(const Unit&) const {}
    __device__ __forceinline__ void done(const Unit&) const {}
};
__host__ __device__ __forceinline__ int tail_splits(int T, int G) { return T == 0 ? 0 : (G / T >= 6 ? 6 : (G / T >= 1 ? G / T : 1)); }
struct MoeTailOrder {
    static constexpr bool GATHER = false, VARK = true;
    const PG8_LAS int* tab; int nN, G, c, npair;
    __device__ __forceinline__ int splits() const { const int P = tab[0]; const long U = (long)P * nN; return tail_splits((int)(U - (U / G) * G), G); }
    __device__ __forceinline__ bool next(int i, Unit& u) const {
        const int P = tab[0]; const long U = (long)P * nN, full = (U / G) * G; const int T = (int)(U - full), s = tail_splits(T, G); const long j = (long)i * G + c; if (s == 0 || j >= (long)T * s) return false;
        const long L = full + j / s; const int ks = (int)(j % s); int pm, pn; moe_unit(L, P, nN, pm, pn); u.pm = pm; u.pn = tab[1 + pm] * nN + pn;
        const int base = npair / s, rem = npair % s, np = base + (ks < rem ? 1 : 0), p0 = ks * base + (ks < rem ? ks : rem);
        u.ko = p0 * 2 * BK; u.kt = (2 * np) | (ks << 8); return true;
    }
    __device__ __forceinline__ void a_ready(const Unit&) const {}
    __device__ __forceinline__ void done(const Unit&) const {}
};
struct SplitOrder {
    static constexpr bool GATHER = false, VARK = false;
    int pm0, nN, nS, ksplit, G, c;
    __device__ __forceinline__ bool next(int i, Unit& u) const { const long L = (long)i * G + c; if (L >= (long)nN * nS) return false; u.pm = pm0; u.pn = (int)(L % nN); u.ko = (int)(L / nN) * ksplit; return true; }
    __device__ __forceinline__ void a_ready(const Unit&) const {}
    __device__ __forceinline__ void done(const Unit&) const {}
};
struct EpiStoreBf16 {
    static constexpr bool PERM = true, AFTER_DRAIN = false, WADJ = true;
    bf16_t* O; int ldc; int pn_mod;
    __device__ __forceinline__ void operator()(const f32x4 (&acc)[2][2][4][2], const Unit& u, int wr, int wc, int fr, int fq) const {
        const int row0 = u.pm * BM + wr * 64 + fr; const int col0 = (u.pn % pn_mod) * BM + wc * 64 + 8 * fq;
#pragma unroll
        for (int ai = 0; ai < 2; ++ai)
#pragma unroll
            for (int m = 0; m < 4; ++m) { bf16_t* rowp = O + (size_t)(row0 + ai * HALF + m * 16) * ldc + col0;
#pragma unroll
                for (int bj = 0; bj < 2; ++bj) { const f32x4 v0 = acc[ai][bj][m][0], v1 = acc[ai][bj][m][1];
                    u32x4 w; w.x = cvt_pk_bf16(v0[0], v0[1]); w.y = cvt_pk_bf16(v0[2], v0[3]); w.z = cvt_pk_bf16(v1[0], v1[1]); w.w = cvt_pk_bf16(v1[2], v1[3]);
                    *(u32x4*)(rowp + bj * 32) = w; } }
    }
};
struct EpiSwiglu {
    static constexpr bool PERM = true, AFTER_DRAIN = false, WADJ = false;
    bf16_t* O; int ldc; int pn_mod;
    __device__ __forceinline__ void operator()(const f32x4 (&acc)[2][2][4][2], const Unit& u, int wr, int wc, int fr, int fq) const {
        const int row0 = u.pm * BM + wr * 64 + fr; const int col0 = (u.pn % pn_mod) * HALF + wc * 32 + 8 * fq;
#pragma unroll
        for (int ai = 0; ai < 2; ++ai)
#pragma unroll
            for (int m = 0; m < 4; ++m) { bf16_t* rowp = O + (size_t)(row0 + ai * HALF + m * 16) * ldc + col0;
                float r[8];
#pragma unroll
                for (int n = 0; n < 2; ++n)
#pragma unroll
                    for (int i = 0; i < 4; ++i) { const float a = acc[ai][0][m][n][i], b = acc[ai][1][m][n][i];
                        const float sg = __builtin_amdgcn_rcpf(1.0f + __builtin_amdgcn_exp2f(-1.44269504089f * a)); r[n * 4 + i] = a * sg * b; }
                u32x4 w; w.x = cvt_pk_bf16(r[0], r[1]); w.y = cvt_pk_bf16(r[2], r[3]); w.z = cvt_pk_bf16(r[4], r[5]); w.w = cvt_pk_bf16(r[6], r[7]);
                *(u32x4*)rowp = w; }
    }
};
struct EpiSwiglu8 {
    static constexpr bool PERM = true, AFTER_DRAIN = false, WADJ = false;
    unsigned char* O; int ldc; int pn_mod; const PG8_LAS unsigned* amax; float sa, so;
    __device__ __forceinline__ void operator()(const f32x4 (&acc)[2][2][4][2], const Unit& u, int wr, int wc, int fr, int fq) const {
        const int row0 = u.pm * BM + wr * 64 + fr; const int col0 = (u.pn % pn_mod) * HALF + wc * 32 + 8 * fq; const int ex = u.pn / pn_mod;
        const float i1 = 1.f / (sa * f8_scale(amax[3 * ex])), i3 = so / (sa * f8_scale(amax[3 * ex + 1]));
#pragma unroll
        for (int ai = 0; ai < 2; ++ai)
#pragma unroll
            for (int m = 0; m < 4; ++m) { unsigned char* rowp = O + (size_t)(row0 + ai * HALF + m * 16) * ldc + col0;
                float r[8];
#pragma unroll
                for (int n = 0; n < 2; ++n)
#pragma unroll
                    for (int i = 0; i < 4; ++i) { const float a = acc[ai][0][m][n][i] * i1, b = acc[ai][1][m][n][i] * i3;
                        const float sg = __builtin_amdgcn_rcpf(1.0f + __builtin_amdgcn_exp2f(-1.44269504089f * a)); r[n * 4 + i] = a * sg * b; }
                uint2 w; w.x = pk4_fp8(r[0], r[1], r[2], r[3]); w.y = pk4_fp8(r[4], r[5], r[6], r[7]);
                *(uint2*)rowp = w; }
    }
};
struct EpiStoreBf16S {
    static constexpr bool PERM = true, AFTER_DRAIN = false, WADJ = false;
    bf16_t* O; int ldc; int pn_mod; const PG8_LAS unsigned* amax; float sa;
    __device__ __forceinline__ void operator()(const f32x4 (&acc)[2][2][4][2], const Unit& u, int wr, int wc, int fr, int fq) const {
        const int row0 = u.pm * BM + wr * 64 + fr; const int col0 = (u.pn % pn_mod) * BM + wc * 32 + 8 * fq; const float inv = 1.f / (sa * f8_scale(amax[3 * (u.pn / pn_mod) + 2]));
#pragma unroll
        for (int ai = 0; ai < 2; ++ai)
#pragma unroll
            for (int m = 0; m < 4; ++m) { bf16_t* rowp = O + (size_t)(row0 + ai * HALF + m * 16) * ldc + col0;
#pragma unroll
                for (int bj = 0; bj < 2; ++bj) { const f32x4 v0 = acc[ai][bj][m][0] * inv, v1 = acc[ai][bj][m][1] * inv;
                    u32x4 w; w.x = cvt_pk_bf16(v0[0], v0[1]); w.y = cvt_pk_bf16(v0[2], v0[3]); w.z = cvt_pk_bf16(v1[0], v1[1]); w.w = cvt_pk_bf16(v1[2], v1[3]);
                    *(u32x4*)(rowp + bj * HALF) = w; } }
    }
};
struct EpiResid {
    static constexpr bool PERM = false, AFTER_DRAIN = false, WADJ = false;
    const float* res0; float* out0; const float* gate0; int ldc;
    __device__ __forceinline__ void operator()(const f32x4 (&acc)[2][2][4][2], const Unit& u, int wr, int wc, int fr, int fq) const {
        const int row0 = u.pm * BM + wr * 64 + fr, col0 = u.pn * BM + wc * 32 + 4 * fq;
        f32x4 gv[2][2];
#pragma unroll
        for (int bj = 0; bj < 2; ++bj)
#pragma unroll
            for (int n = 0; n < 2; ++n) gv[bj][n] = *(const f32x4*)(gate0 + col0 + bj * HALF + n * 16);
#pragma unroll
        for (int ai = 0; ai < 2; ++ai) {
            f32x4 r[4][2][2];
#pragma unroll
            for (int m = 0; m < 4; ++m) { const size_t off = (size_t)(row0 + ai * HALF + m * 16) * ldc + col0;
#pragma unroll
                for (int bj = 0; bj < 2; ++bj)
#pragma unroll
                    for (int n = 0; n < 2; ++n) r[m][bj][n] = *(const f32x4*)(res0 + off + bj * HALF + n * 16); }
#pragma unroll
            for (int m = 0; m < 4; ++m) { const size_t off = (size_t)(row0 + ai * HALF + m * 16) * ldc + col0;
#pragma unroll
                for (int bj = 0; bj < 2; ++bj)
#pragma unroll
                    for (int n = 0; n < 2; ++n) *(f32x4*)(out0 + off + bj * HALF + n * 16) = r[m][bj][n] + gv[bj][n] * acc[ai][bj][m][n]; }
        }
    }
};

struct EpiPartial {
    static constexpr bool PERM = false, AFTER_DRAIN = false, WADJ = false;
    float* P; int ksplit; int ldc;
    __device__ __forceinline__ void operator()(const f32x4 (&acc)[2][2][4][2], const Unit& u, int wr, int wc, int fr, int fq) const {
        const int row0 = wr * 64 + fr, col0 = u.pn * BM + wc * 32 + 4 * fq; float* base = P + (size_t)(u.ko / ksplit) * BM * ldc;
#pragma unroll
        for (int ai = 0; ai < 2; ++ai)
#pragma unroll
            for (int m = 0; m < 4; ++m) { float* rp = base + (size_t)(row0 + ai * HALF + m * 16) * ldc + col0;
#pragma unroll
                for (int bj = 0; bj < 2; ++bj)
#pragma unroll
                    for (int n = 0; n < 2; ++n) *(f32x4*)(rp + bj * HALF + n * 16) = acc[ai][bj][m][n]; }
    }
};
template <bool RES32> struct EpiResidB {
    static constexpr bool PERM = true, AFTER_DRAIN = false, WADJ = false;
    const float* res32; bf16_t* xb; const float* gate; int ldc;
    __device__ __forceinline__ void operator()(const f32x4 (&acc)[2][2][4][2], const Unit& u, int wr, int wc, int fr, int fq) const {
        const int row0 = u.pm * BM + wr * 64 + fr; const int col0 = u.pn * BM + wc * 32 + 8 * fq;
        f32x4 gv[2][2];
#pragma unroll
        for (int bj = 0; bj < 2; ++bj)
#pragma unroll
            for (int n = 0; n < 2; ++n) gv[bj][n] = *(const f32x4*)(gate + col0 + bj * HALF + 4 * n);
#pragma unroll
        for (int ai = 0; ai < 2; ++ai) {
            f32x4 r[4][2][2];
#pragma unroll
            for (int m = 0; m < 4; ++m) { const size_t off = (size_t)(row0 + ai * HALF + m * 16) * ldc + col0;
#pragma unroll
                for (int bj = 0; bj < 2; ++bj) {
                    if constexpr (RES32) { r[m][bj][0] = *(const f32x4*)(res32 + off + bj * HALF); r[m][bj][1] = *(const f32x4*)(res32 + off + bj * HALF + 4); }
                    else { const u32x4 w = *(const u32x4*)(xb + off + bj * HALF);
                        r[m][bj][0] = (f32x4){__uint_as_float(w.x << 16), __uint_as_float(w.x & 0xffff0000u), __uint_as_float(w.y << 16), __uint_as_float(w.y & 0xffff0000u)};
                        r[m][bj][1] = (f32x4){__uint_as_float(w.z << 16), __uint_as_float(w.z & 0xffff0000u), __uint_as_float(w.w << 16), __uint_as_float(w.w & 0xffff0000u)}; } } }
#pragma unroll
            for (int m = 0; m < 4; ++m) { const size_t off = (size_t)(row0 + ai * HALF + m * 16) * ldc + col0;
#pragma unroll
                for (int bj = 0; bj < 2; ++bj) { const f32x4 v0 = r[m][bj][0] + gv[bj][0] * acc[ai][bj][m][0], v1 = r[m][bj][1] + gv[bj][1] * acc[ai][bj][m][1];
                    u32x4 w; w.x = cvt_pk_bf16(v0[0], v0[1]); w.y = cvt_pk_bf16(v0[2], v0[3]); w.z = cvt_pk_bf16(v1[0], v1[1]); w.w = cvt_pk_bf16(v1[2], v1[3]);
                    *(u32x4*)(xb + off + bj * HALF) = w; } }
        }
    }
};
struct EpiTailPartial {
    static constexpr bool PERM = false, AFTER_DRAIN = false, WADJ = false;
    float* PT; int P, nN, full, tcap; const PG8_LAS unsigned* amax; float sa;
    __device__ __forceinline__ void operator()(const f32x4 (&acc)[2][2][4][2], const Unit& u, int wr, int wc, int fr, int fq) const {
        const int idx = moe_index(u.pm, u.pn % nN, P, nN) - full, s = u.kt >> 8; const float inv = 1.f / (sa * f8_scale(amax[3 * (u.pn / nN) + 2]));
        float* base = PT + (size_t)(s * tcap + idx) * (BM * BM) + (size_t)(wr * 64 + fr) * BM + wc * 32 + 4 * fq;
#pragma unroll
        for (int ai = 0; ai < 2; ++ai)
#pragma unroll
            for (int m = 0; m < 4; ++m) { float* rp = base + (size_t)(ai * HALF + m * 16) * BM;
#pragma unroll
                for (int bj = 0; bj < 2; ++bj)
#pragma unroll
                    for (int n = 0; n < 2; ++n) *(f32x4*)(rp + bj * HALF + n * 16) = acc[ai][bj][m][n] * inv; }
    }
};
template <class Epi, class Sched, bool ALIGN_EPI = false, bool SP2 = false, bool FP8 = false>
__device__ __forceinline__ void gemm_phase(PG8_LAS unsigned char* lds, const Gemm g, const Sched& S, const Epi& E) {
    int tid_ = threadIdx.x; asm volatile("" : "+v"(tid_)); const int tid = tid_, wid = __builtin_amdgcn_readfirstlane(tid >> 6), lane = tid & 63, wr = wid >> 2, wc = wid & 3, fr = lane & 15, fq = lane >> 4;
    const int K = g.ld; int nt = g.K / BK;
    unsigned voffA[2], voffB[2];
#pragma unroll
    for (int i = 0; i < 2; ++i) { int R, C; stage_rc(tid * 16 + i * 8192, R, C); const int Rb = Epi::WADJ ? ((R >> 5) * 64 + perm32(R & 31)) : (Epi::PERM ? ((R & ~31) + perm32(R & 31)) : R);
        voffA[i] = (unsigned)(R * K + C) * 2u; voffB[i] = (unsigned)(Rb * K + C) * 2u; }
    const size_t kstep = (size_t)(BK * 2);
    const size_t hstep = (size_t)HALF * K * 2;
    const size_t hstepB = Epi::WADJ ? (size_t)32 * K * 2 : hstep;
    const size_t tstep = 2 * hstep;
    const unsigned ldsw = (unsigned)wid * 1024u;
    const int aoff = lds_byte(wr * 64 + fr, fq * 8), boff = lds_byte(wc * 32 + fr, fq * 8);
#define PG8_SA(b, h) (((b) * 2 + (h)) * HTB)
#define PG8_SB(b, h) ((4 + (b) * 2 + (h)) * HTB)
#define PG8_STAGE(bufoff, gbase, voff) do { _Pragma("unroll") for (int _i = 0; _i < 2; ++_i) \
        __builtin_amdgcn_global_load_lds((const unsigned*)((const char*)(gbase) + (voff)[_i]), (PG8_LAS unsigned*)(lds + (bufoff) + ldsw + _i * 8192), 16, 0, 0); } while (0)
#define PG8_LD8(p) __builtin_shufflevector(*(const PG8_LAS i32x4*)(p), *(const PG8_LAS i32x4*)((p) + 1024), 0, 1, 2, 3, 4, 5, 6, 7)
#define PG8_LDA(dst, b, h) do { if constexpr (FP8) { _Pragma("unroll") for (int m = 0; m < 4; ++m) dst##8[m] = PG8_LD8(lds + PG8_SA(b, h) + aoff + m * 2048); } else { \
        _Pragma("unroll") for (int m = 0; m < 4; ++m) _Pragma("unroll") for (int k = 0; k < 2; ++k) dst[m][k] = *(const PG8_LAS bf16x8*)(lds + PG8_SA(b, h) + aoff + m * 2048 + k * 1024); } } while (0)
#define PG8_LDB(dst, b, h) do { if constexpr (FP8) { _Pragma("unroll") for (int n = 0; n < 2; ++n) dst##8[n] = PG8_LD8(lds + PG8_SB(b, h) + boff + n * 2048); } else { \
        _Pragma("unroll") for (int n = 0; n < 2; ++n) _Pragma("unroll") for (int k = 0; k < 2; ++k) dst[n][k] = *(const PG8_LAS bf16x8*)(lds + PG8_SB(b, h) + boff + n * 2048 + k * 1024); } } while (0)
#define PG8_CAT8(x, y) __builtin_shufflevector(__builtin_bit_cast(i32x4, x), __builtin_bit_cast(i32x4, y), 0, 1, 2, 3, 4, 5, 6, 7)
#define PG8_MMA(ai, bj, At, Bt) do { __builtin_amdgcn_s_setprio(1); if constexpr (FP8) { _Pragma("unroll") for (int m = 0; m < 4; ++m) _Pragma("unroll") for (int n = 0; n < 2; ++n) \
        asm volatile("v_mfma_f32_16x16x128_f8f6f4 %0, %1, %2, %0" : "+v"(acc[ai][bj][m][n]) : "v"(Bt##8[n]), "v"(At##8[m])); } else { \
        _Pragma("unroll") for (int m = 0; m < 4; ++m) _Pragma("unroll") for (int n = 0; n < 2; ++n) _Pragma("unroll") for (int k = 0; k < 2; ++k) \
        acc[ai][bj][m][n] = __builtin_amdgcn_mfma_f32_16x16x32_bf16(Bt[n][k], At[m][k], acc[ai][bj][m][n], 0, 0, 0); } __builtin_amdgcn_s_setprio(0); } while (0)
#define PG8_WAIT_V(n) asm volatile("s_waitcnt vmcnt(" #n ")" ::: "memory")
#define PG8_WAIT_L(n) asm volatile("s_waitcnt lgkmcnt(" #n ")" ::: "memory")
#define PG8_BAR __builtin_amdgcn_s_barrier()
#define PG8_SCHED __builtin_amdgcn_sched_barrier(0)
    Unit cur, nxt; int ui = 0;
    if (!S.next(0, cur)) return;
    if constexpr (Sched::VARK) nt = cur.kt & 255;
    unsigned va[2][2], vn[2][2]; int gR[2], gC[2];
    if constexpr (Sched::GATHER) {
#pragma unroll
        for (int i = 0; i < 2; ++i) { stage_rc(tid * 16 + i * 8192, gR[i], gC[i]); }
#pragma unroll
        for (int h = 0; h < 2; ++h)
#pragma unroll
            for (int i = 0; i < 2; ++i) { va[h][i] = (unsigned)(S.arow(cur, 128 * h + gR[i]) * K + gC[i]) * 2u; vn[h][i] = va[h][i]; }
    }
#define PG8_STAGEA(bufoff, gbase, h, nx) do { if constexpr (Sched::GATHER) { _Pragma("unroll") for (int _i = 0; _i < 2; ++_i) { const unsigned _vo = (nx) ? vn[h][_i] : va[h][_i]; \
        __builtin_amdgcn_global_load_lds((const unsigned*)((const char*)(gbase) + _vo), (PG8_LAS unsigned*)(lds + (bufoff) + ldsw + _i * 8192), 16, 0, 0); } } \
        else { PG8_STAGE(bufoff, (gbase) + ((h) ? hstep : 0), voffA); } } while (0)
    f32x4 acc[2][2][4][2];
#pragma unroll
    for (int a = 0; a < 2; ++a)
#pragma unroll
        for (int b = 0; b < 2; ++b)
#pragma unroll
            for (int m = 0; m < 4; ++m)
#pragma unroll
                for (int n = 0; n < 2; ++n) acc[a][b][m][n] = (f32x4){0.f, 0.f, 0.f, 0.f};
    bf16x8 At[4][2], B0[2][2], B1[2][2]; i32x8 At8[4], B08[2], B18[2];
    const char* cA = (const char*)g.A + (Sched::GATHER ? (size_t)0 : (size_t)cur.pm * tstep) + (size_t)cur.ko * 2; const char* cB = (const char*)g.Bt + (size_t)cur.pn * tstep + (size_t)cur.ko * 2;
    S.a_ready(cur);
    if constexpr (SP2) {
        PG8_STAGE(PG8_SB(0, 0), cB, voffB); PG8_STAGE(PG8_SB(0, 1), cB + hstepB, voffB); PG8_STAGEA(PG8_SA(0, 0), cA, 0, false); PG8_STAGEA(PG8_SA(0, 1), cA, 1, false);
        if (wr == 1) PG8_BAR;
        PG8_WAIT_V(2); PG8_BAR;
        PG8_STAGE(PG8_SB(1, 0), cB + kstep, voffB); PG8_STAGEA(PG8_SA(1, 0), cA + kstep, 0, false); PG8_STAGE(PG8_SB(1, 1), cB + hstepB + kstep, voffB);
        PG8_WAIT_V(6); PG8_BAR;
    } else {
        PG8_STAGE(PG8_SB(0, 0), cB, voffB); PG8_STAGEA(PG8_SA(0, 0), cA, 0, false); PG8_STAGE(PG8_SB(0, 1), cB + hstepB, voffB); PG8_STAGEA(PG8_SA(0, 1), cA, 1, false);
        if (wr == 1) PG8_BAR;
        PG8_WAIT_V(4); PG8_BAR;
        PG8_STAGE(PG8_SB(1, 0), cB + kstep, voffB); PG8_STAGEA(PG8_SA(1, 0), cA + kstep, 0, false); PG8_STAGE(PG8_SB(1, 1), cB + hstepB + kstep, voffB);
        PG8_WAIT_V(6); PG8_BAR;
    }
    for (;;) {
        const bool has_next = S.next(ui + 1, nxt);
        if constexpr (Sched::GATHER) { if (has_next) {
#pragma unroll
            for (int h = 0; h < 2; ++h)
#pragma unroll
                for (int i = 0; i < 2; ++i) vn[h][i] = (unsigned)(S.arow(nxt, 128 * h + gR[i]) * K + gC[i]) * 2u; }
            else {
#pragma unroll
                for (int h = 0; h < 2; ++h)
#pragma unroll
                    for (int i = 0; i < 2; ++i) vn[h][i] = va[h][i]; } }
        const char* nA = has_next ? (const char*)g.A + (Sched::GATHER ? (size_t)0 : (size_t)nxt.pm * tstep) + (size_t)nxt.ko * 2 : cA; const char* nB = has_next ? (const char*)g.Bt + (size_t)nxt.pn * tstep + (size_t)nxt.ko * 2 : cB;
        for (int t = 0; t < nt; t += 2) {
            const bool last = (t == nt - 2);
            const char* a1 = cA + (size_t)(t + 1) * kstep;
            const char* a2 = last ? nA : cA + (size_t)(t + 2) * kstep; const char* b2 = last ? nB : cB + (size_t)(t + 2) * kstep;
            const char* a3 = a2 + kstep; const char* b3 = b2 + kstep;
            if (last && has_next) S.a_ready(nxt);
            if constexpr (SP2) {
            PG8_LDB(B0, 0, 0); PG8_LDB(B1, 0, 1); PG8_SCHED; PG8_LDA(At, 0, 0); PG8_STAGEA(PG8_SA(1, 1), a1, 1, false);
            PG8_WAIT_V(8); PG8_WAIT_L(0); PG8_BAR; PG8_MMA(0, 0, At, B0); PG8_MMA(0, 1, At, B1); PG8_BAR; PG8_SCHED;
            PG8_LDA(At, 0, 1); PG8_STAGE(PG8_SB(0, 0), b2, voffB); PG8_STAGE(PG8_SB(0, 1), b2 + hstepB, voffB); PG8_STAGEA(PG8_SA(0, 0), a2, 0, last);
            PG8_WAIT_V(8); PG8_WAIT_L(0); PG8_BAR; PG8_MMA(1, 0, At, B0); PG8_MMA(1, 1, At, B1); PG8_BAR; PG8_SCHED;
            PG8_LDB(B0, 1, 0); PG8_LDB(B1, 1, 1); PG8_SCHED; PG8_LDA(At, 1, 0); PG8_STAGEA(PG8_SA(0, 1), a2, 1, last);
            PG8_WAIT_V(8); PG8_WAIT_L(0); PG8_BAR; PG8_MMA(0, 0, At, B0); PG8_MMA(0, 1, At, B1); PG8_BAR; PG8_SCHED;
            PG8_LDA(At, 1, 1); PG8_STAGE(PG8_SB(1, 0), b3, voffB); PG8_STAGE(PG8_SB(1, 1), b3 + hstepB, voffB); PG8_STAGEA(PG8_SA(1, 0), a3, 0, last);
            PG8_WAIT_V(8); PG8_WAIT_L(0); PG8_BAR; PG8_MMA(1, 0, At, B0); PG8_MMA(1, 1, At, B1); PG8_BAR; PG8_SCHED;
            } else {
            PG8_LDB(B0, 0, 0); PG8_SCHED; PG8_LDA(At, 0, 0); PG8_STAGEA(PG8_SA(1, 1), a1, 1, false);
            PG8_WAIT_L(8); PG8_BAR; PG8_WAIT_L(0); PG8_MMA(0, 0, At, B0); PG8_BAR; PG8_SCHED;
            PG8_LDB(B1, 0, 1); PG8_STAGE(PG8_SB(0, 0), b2, voffB);
            PG8_BAR; PG8_WAIT_L(0); PG8_MMA(0, 1, At, B1); PG8_BAR;
            PG8_LDA(At, 0, 1); PG8_STAGEA(PG8_SA(0, 0), a2, 0, last);
            PG8_BAR; PG8_WAIT_L(0); PG8_MMA(1, 0, At, B0); PG8_BAR; PG8_SCHED;
            PG8_STAGE(PG8_SB(0, 1), b2 + hstepB, voffB);
            PG8_WAIT_V(6); PG8_BAR; PG8_MMA(1, 1, At, B1); PG8_BAR;
            PG8_LDB(B0, 1, 0); PG8_SCHED; PG8_LDA(At, 1, 0); PG8_STAGEA(PG8_SA(0, 1), a2, 1, last);
            PG8_WAIT_L(8); PG8_BAR; PG8_WAIT_L(0); PG8_MMA(0, 0, At, B0); PG8_BAR; PG8_SCHED;
            PG8_LDB(B1, 1, 1); PG8_STAGE(PG8_SB(1, 0), b3, voffB);
            PG8_BAR; PG8_WAIT_L(0); PG8_MMA(0, 1, At, B1); PG8_BAR;
            PG8_LDA(At, 1, 1); PG8_STAGEA(PG8_SA(1, 0), a3, 0, last);
            PG8_BAR; PG8_WAIT_L(0); PG8_MMA(1, 0, At, B0); PG8_BAR; PG8_SCHED;
            PG8_STAGE(PG8_SB(1, 1), b3 + hstepB, voffB);
            PG8_WAIT_V(6); PG8_BAR; PG8_MMA(1, 1, At, B1); PG8_BAR;
            }
        }
        if constexpr (ALIGN_EPI) { if (wr == 0) PG8_BAR; }
        if constexpr (FP8) asm volatile("s_nop 15\n\ts_nop 15\n\ts_nop 15" ::: "memory");
        if constexpr (!Epi::AFTER_DRAIN) { E(acc, cur, wr, wc, fr, fq); S.done(cur); }
        if (!has_next) break;
#pragma unroll
        for (int a = 0; a < 2; ++a)
#pragma unroll
            for (int b = 0; b < 2; ++b)
#pragma unroll
                for (int m = 0; m < 4; ++m)
#pragma unroll
                    for (int n = 0; n < 2; ++n) acc[a][b][m][n] = (f32x4){0.f, 0.f, 0.f, 0.f};
        cur = nxt; cA = nA; cB = nB; ++ui;
        if constexpr (Sched::VARK) nt = cur.kt & 255;
        if constexpr (Sched::GATHER) {
#pragma unroll
            for (int h = 0; h < 2; ++h)
#pragma unroll
                for (int i = 0; i < 2; ++i) va[h][i] = vn[h][i]; }
        if constexpr (ALIGN_EPI) { if (wr == 1) PG8_BAR; }
    }
    PG8_WAIT_V(0);
    if constexpr (!ALIGN_EPI) { if (wr == 0) PG8_BAR; }
    PG8_BAR;
    if constexpr (Epi::AFTER_DRAIN) { E.fused(acc, cur, wr, wc, fr, fq, lds, wid, lane); S.done(cur); }
#undef PG8_SA
#undef PG8_SB
#undef PG8_STAGE
#undef PG8_STAGEA
#undef PG8_LDA
#undef PG8_LD8
#undef PG8_LDB
#undef PG8_MMA
#undef PG8_CAT8
#undef PG8_WAIT_V
#undef PG8_WAIT_L
#undef PG8_BAR
#undef PG8_SCHED
}
}

constexpr int DM = 2048, SEQ = 16384, CTXN = 256, NROW = SEQ + CTXN, HD = 128, INC = 5632, DFF = 5632, NEXP = 8;
constexpr int C_QA = 0, C_KA = 1024, C_VA = 1280, C_QR = 1536, C_KR = 2560, C_VR = 3584, C_GR = 4608;
constexpr int NBLK = NROW / 128;
constexpr int PMAX = 136;
constexpr float EPS = 1e-6f;
constexpr int NWAVES = 8, NTHR = 512;

constexpr size_t MiB = 1u << 20;
constexpr size_t WS_CTL = 0, CTL_ZERO_BYTES = 1 * MiB;
constexpr size_t WS_MODS = 1 * MiB;
constexpr size_t WS_PART = 2 * MiB;
constexpr size_t WS_ROPE = 5 * MiB;
constexpr size_t WS_SEL = 6 * MiB;
constexpr size_t WS_SLOTTOK = 6 * MiB + 512 * 1024;
constexpr size_t WS_SLOTG = 6 * MiB + 768 * 1024;
constexpr size_t WS_TOKSLOT = 7 * MiB;
constexpr size_t WS_RBCNT = 8 * MiB;
constexpr size_t WS_PTAB = 8 * MiB + 65536;
constexpr size_t WS_XCTX = 10 * MiB;
constexpr size_t WS_WIN = 16 * MiB;
constexpr size_t WS_WOUT = 60 * MiB;
constexpr size_t WS_WF13 = 76 * MiB;
constexpr size_t WS_WF2 = 120 * MiB;
constexpr size_t WS_WM13 = 142 * MiB;
constexpr size_t WS_WM2 = 494 * MiB;
constexpr size_t WS_H = 670 * MiB;
constexpr size_t WS_RA = 735 * MiB;
constexpr size_t WS_PROJ = WS_RA, WS_KV = WS_RA + 179 * MiB, WS_SPREV = WS_RA + 309 * MiB, WS_U = WS_RA;
constexpr size_t WS_RB = 1109 * MiB;
constexpr size_t WS_MIX = WS_RB, WS_VAT = WS_RB + 65 * MiB, WS_VRT = WS_RB + 107 * MiB, WS_H2G = WS_RB;
constexpr size_t WS_YP = 1249 * MiB;
constexpr size_t WS_PC1 = 1385 * MiB;
constexpr size_t WS_PC2 = 1401 * MiB;
constexpr size_t WS_XB = 1423 * MiB;
constexpr size_t WS_PT = 1487 * MiB;
constexpr size_t WS_END = 1551 * MiB;
static_assert((size_t)NROW * INC * 2 <= 179 * MiB && (size_t)NBLK * 8 * 2 * 128 * 128 * 4 <= 130 * MiB && (size_t)NBLK * 8 * 2 * 128 * 128 * 2 <= 65 * MiB && (size_t)PMAX * 256 * DFF * 2 <= 374 * MiB, "region A");
static_assert((size_t)NROW * DM * 2 <= 65 * MiB && (size_t)NBLK * 2 * 128 * 128 * 2 <= 9 * MiB && (size_t)NBLK * 8 * 128 * 128 * 2 <= 33 * MiB && (size_t)PMAX * 256 * DM * 2 <= 140 * MiB, "region B");
constexpr int CW_AMAX = 16384;
constexpr float F8_SH = 2.f, F8_SU = 2.f;
constexpr int CW_BAR = 4096;

constexpr int SCR_OFF = 143360;
constexpr int MISC_OFF = 147456;
constexpr int LDS_BYTES = 151552;

#define GAS __attribute__((address_space(1)))
#define LAS __attribute__((address_space(3)))
#define DI __device__ __forceinline__
typedef unsigned short bf16;
typedef unsigned v4u __attribute__((ext_vector_type(4)));
typedef unsigned v2u __attribute__((ext_vector_type(2)));
typedef float f32x4 __attribute__((ext_vector_type(4)));
typedef float f32x2 __attribute__((ext_vector_type(2)));
typedef short bf16x8 __attribute__((ext_vector_type(8)));
#define LDS_WAIT() asm volatile("s_waitcnt lgkmcnt(0)" ::: "memory")
#define VM_WAIT() asm volatile("s_waitcnt vmcnt(0)" ::: "memory")
#define MFMA16(a, b, c) __builtin_amdgcn_mfma_f32_16x16x32_bf16((a), (b), (c), 0, 0, 0)
DI unsigned pk2(float lo, float hi) { return pg8::cvt_pk_bf16(lo, hi); }
DI unsigned pk2_safe(float lo, float hi) { const unsigned a = __float_as_uint(lo), b = __float_as_uint(hi); return ((a + 0x7fffu + ((a >> 16) & 1u)) >> 16) | ((b + 0x7fffu + ((b >> 16) & 1u)) & 0xffff0000u); }
DI float bflo(unsigned w) { return __uint_as_float(w << 16); }
DI float bfhi(unsigned w) { return __uint_as_float(w & 0xffff0000u); }
DI float ex2(float x) { return __builtin_amdgcn_exp2f(x); }
DI float wave_sum(float v) {
#pragma unroll
    for (int o = 1; o < 64; o <<= 1) v += __shfl_xor(v, o);
    return v;
}

#define XB_TMO      128
#define XB_XCNT(j)  (256  + 64 * (j))
#define XB_XSUB(j)  (1280 + 64 * (j))
#define XB_XGEN(j)  (2304 + 64 * (j))
#define XB_TOP      3328
#define XB_TOPGEN   3392
#define XCD_BAR_WORDS 3456
#define XB_SPIN_CAP (1u << 18)

__device__ __forceinline__ unsigned xb_ld(unsigned* p)              { return __hip_atomic_load(p, __ATOMIC_RELAXED, __HIP_MEMORY_SCOPE_AGENT); }
__device__ __forceinline__ unsigned xb_add(unsigned* p, unsigned v) { return __hip_atomic_fetch_add(p, v, __ATOMIC_RELAXED, __HIP_MEMORY_SCOPE_AGENT); }
__device__ __forceinline__ unsigned xb_xcc_id() { return (unsigned)__builtin_amdgcn_s_getreg((3 << 11) | 20) & 0xFu; }
#define XB_SPIN(cond, bar) do { unsigned _sp = 0; while (cond) { __builtin_amdgcn_s_sleep(1); \
    if ((++_sp & 255u) == 0u) { if (xb_ld(&(bar)[XB_TMO])) break; if (_sp > XB_SPIN_CAP) { atomicAdd(&(bar)[XB_TMO], 1u); break; } } } } while (0)

struct XcdBarrier {
    unsigned* bar; unsigned x;
    volatile LAS unsigned* st;
};

__device__ __forceinline__ XcdBarrier xcd_barrier_post(unsigned* bar, volatile LAS unsigned* st) {
    XcdBarrier b; b.bar = bar; b.x = xb_xcc_id(); b.st = st;
    if (threadIdx.x == 0) (void)xb_add(&bar[XB_XCNT(b.x)], 1u);
    return b;
}
__device__ __forceinline__ void xcd_barrier_complete(unsigned* bar, unsigned x, unsigned& nloc, unsigned& nx) {
    const unsigned G = gridDim.x * gridDim.y * gridDim.z;
    unsigned sum, cnt, mine, sp = 0u;
    for (;;) {
        sum = 0u; cnt = 0u; mine = 0u;
#pragma unroll
        for (unsigned j = 0; j < 16; ++j) { const unsigned c = xb_ld(&bar[XB_XCNT(j)]); sum += c; cnt += (c > 0u) ? 1u : 0u; mine = (j == x) ? c : mine; }
        if (sum == G) break;
        __builtin_amdgcn_s_sleep(1);
        if ((++sp & 255u) == 0u) { if (xb_ld(&bar[XB_TMO])) break; if (sp > XB_SPIN_CAP) { atomicAdd(&bar[XB_TMO], 1u); break; } }
    }
    nloc = mine > 0u ? mine : 1u; nx = cnt > 0u ? cnt : 1u;
}

__device__ __forceinline__ void xcd_barrier(const XcdBarrier& b) {
    asm volatile("s_waitcnt vmcnt(0)" ::: "memory");
    __syncthreads();
    if (threadIdx.x == 0) {
        unsigned* bar = b.bar;
        __builtin_amdgcn_s_waitcnt(0);
        unsigned nloc = b.st[0], nx = b.st[1];
        if (nloc == 0u) { xcd_barrier_complete(bar, b.x, nloc, nx); b.st[0] = nloc; b.st[1] = nx; }
        const unsigned old = xb_add(&bar[XB_XSUB(b.x)], 1u);
        const unsigned gen = old / nloc;
        if (old + 1u == (gen + 1u) * nloc) {
            __builtin_amdgcn_fence(__ATOMIC_RELEASE, "agent");
            asm volatile("s_waitcnt vmcnt(0)" ::: "memory");
            const unsigned og = xb_add(&bar[XB_TOP], 1u);
            const unsigned tg = og / nx;
            if (og + 1u == (tg + 1u) * nx) xb_add(&bar[XB_TOPGEN], 1u);
            else XB_SPIN(xb_ld(&bar[XB_TOPGEN]) == tg, bar);
            __builtin_amdgcn_fence(__ATOMIC_ACQUIRE, "agent");
            xb_add(&bar[XB_XGEN(b.x)], 1u);
            asm volatile("s_waitcnt vmcnt(0)" ::: "memory");
        } else {
            XB_SPIN(xb_ld(&bar[XB_XGEN(b.x)]) == gen, bar);
            __builtin_amdgcn_fence(__ATOMIC_ACQUIRE, "agent");
            asm volatile("s_waitcnt vmcnt(0)" ::: "memory");
        }
    }
    __syncthreads();
}

struct Args { const float* in[23]; float* out; unsigned char* ws; int ph_lo, ph_hi; };
struct Frame {
    LAS unsigned char* lds;
    int tid, lane, wave, G, bx;
    const __attribute__((address_space(4))) Args* a;
};
#define FW(T, off) ((T*)(F.a->ws + (off)))
DI Frame launder(const Frame& F0) { Frame F = F0; asm volatile("" : "+v"(F.tid)); const __attribute__((address_space(4))) Args* a = F0.a; asm volatile("" : "+s"(a)); F.a = a; F.lane = F.tid & 63; F.wave = __builtin_amdgcn_readfirstlane(F.tid >> 6); return F; }

enum { I_X = 0, I_C, I_CTX, I_CCTX, I_ADAW, I_ADAB, I_N1G, I_N2G, I_WIN, I_QG, I_KG, I_SINK, I_DECAY, I_GNG, I_WOUT, I_F1, I_F3, I_F2, I_RW, I_RB, I_M1, I_M3, I_M2 };

DI void ph_ada(const Frame& F0) { const Frame F = launder(F0);
    LAS float* sc = (LAS float*)F.lds;
    for (int i = F.tid; i < 2048; i += NTHR) { const float a = F.a->in[I_C][i], b = F.a->in[I_CCTX][i]; sc[i] = a / (1.f + expf(-a)); sc[2048 + i] = b / (1.f + expf(-b)); }
    __syncthreads();
    const int gw = F.bx * NWAVES + F.wave, NGW = F.G * NWAVES;
    for (int it = gw; it < 1536; it += NGW) {
        const int l = it / 768, r = it % 768, ks = r / 48, cg = r % 48;
        const GAS float* W = (const GAS float*)F.a->in[I_ADAW] + (size_t)l * 2048 * 12288 + (size_t)(ks * 128) * 12288 + cg * 256 + F.lane * 4;
        f32x4 a0 = (f32x4){0.f, 0.f, 0.f, 0.f}, a1 = a0;
#pragma unroll 8
        for (int k = 0; k < 128; ++k) { const f32x4 w = __builtin_nontemporal_load((const GAS f32x4*)(W + (size_t)k * 12288)); const float s0 = sc[ks * 128 + k], s1 = sc[2048 + ks * 128 + k]; a0 += s0 * w; a1 += s1 * w; }
        float* P = FW(float, WS_PART) + ((size_t)(l * 16 + ks) * 2) * 12288 + cg * 256 + F.lane * 4;
        *(f32x4*)P = a0; *(f32x4*)(P + 12288) = a1;
    }
    unsigned* AMAX = (unsigned*)(F.a->ws + WS_CTL) + CW_AMAX;
    for (int it = NGW - 1 - gw; it < 8 * 608; it += NGW) { const int e = it / 608, r = it % 608; const int k = r < 128 ? 0 : (r < 256 ? 1 : 2), row = (r - (k == 0 ? 0 : (k == 1 ? 128 : 256))) * 16, N = k == 2 ? DM : DFF;
        const float* W = (k == 0 ? F.a->in[I_M1] : (k == 1 ? F.a->in[I_M3] : F.a->in[I_M2])) + (size_t)e * DM * DFF;
        const GAS f32x4* p = (const GAS f32x4*)(W + (size_t)row * N) + F.lane; float m = 0.f;
        if (k == 2) { f32x4 v[8];
#pragma unroll
            for (int j = 0; j < 8; ++j) v[j] = p[64 * j];
#pragma unroll
            for (int j = 0; j < 8; ++j) m = fmaxf(m, fmaxf(fmaxf(fabsf(v[j].x), fabsf(v[j].y)), fmaxf(fabsf(v[j].z), fabsf(v[j].w)))); }
        else { f32x4 v[22];
#pragma unroll
            for (int j = 0; j < 22; ++j) v[j] = p[64 * j];
#pragma unroll
            for (int j = 0; j < 22; ++j) m = fmaxf(m, fmaxf(fmaxf(fabsf(v[j].x), fabsf(v[j].y)), fmaxf(fabsf(v[j].z), fabsf(v[j].w)))); }
#pragma unroll
        for (int o = 1; o < 64; o <<= 1) m = fmaxf(m, __shfl_xor(m, o));
        if (F.lane == 0) __hip_atomic_fetch_max(AMAX + 3 * e + k, __float_as_uint(m), __ATOMIC_RELAXED, __HIP_MEMORY_SCOPE_AGENT); }
    for (int i = F.bx * NTHR + F.tid; i < 8192; i += F.G * NTHR) { const int pos = i >> 5, p = i & 31; const float inv = exp2f(-(float)p * (13.287712379549449f / 32.f)); const float ang = (float)pos * inv;
        FW(float, WS_ROPE)[i] = cosf(ang); (FW(float, WS_ROPE) + 8192)[i] = sinf(ang); }
    __syncthreads();
}

DI void cvt_item(const float* W, int K, int N, bf16* WT, int mode, LAS float* scr, int item, int lane) {
    const int nblk = N / 32, kb = item / nblk, nb = item % nblk, k0 = 128 * kb, n0 = 32 * nb;
    const int r0 = mode ? ((n0 >> 7) * 256 + (n0 & 127) + (mode == 2 ? 128 : 0)) : n0;
    const GAS float* Wg = (const GAS float*)W;
    float tv[64];
#pragma unroll
    for (int i = 0; i < 64; ++i) tv[i] = __builtin_nontemporal_load(Wg + (size_t)(k0 + 2 * i + (lane >> 5)) * N + n0 + (lane & 31));
#pragma unroll
    for (int i = 0; i < 64; ++i) scr[(2 * i + (lane >> 5)) * 33 + (lane & 31)] = tv[i];
    LDS_WAIT(); asm volatile("" ::: "memory");
    const int c = lane & 15;
#pragma unroll
    for (int j = 0; j < 8; ++j) { const int n = (lane >> 4) + 4 * j; const LAS float* s = scr + (8 * c) * 33 + n;
        v4u o; o.x = pk2(s[0 * 33], s[1 * 33]); o.y = pk2(s[2 * 33], s[3 * 33]); o.z = pk2(s[4 * 33], s[5 * 33]); o.w = pk2(s[6 * 33], s[7 * 33]);
        *(GAS v4u*)(WT + (size_t)(r0 + n) * K + k0 + 8 * c) = o; }
    LDS_WAIT(); asm volatile("" ::: "memory");
}
DI void cvt8_item(const float* W, int K, int N, unsigned char* WT, int mode, LAS float* scr, int item, int lane, float sc) {
    const int nblk = N / 32, kb = item / nblk, nb = item % nblk, k0 = 128 * kb, n0 = 32 * nb;
    const int r0 = mode ? ((n0 >> 7) * 256 + (n0 & 127) + (mode == 2 ? 128 : 0)) : n0;
    const GAS float* Wg = (const GAS float*)W;
    float tv[64];
#pragma unroll
    for (int i = 0; i < 64; ++i) tv[i] = __builtin_nontemporal_load(Wg + (size_t)(k0 + 2 * i + (lane >> 5)) * N + n0 + (lane & 31));
#pragma unroll
    for (int i = 0; i < 64; ++i) scr[(2 * i + (lane >> 5)) * 33 + (lane & 31)] = tv[i] * sc;
    LDS_WAIT(); asm volatile("" ::: "memory");
    const int c = lane & 7;
#pragma unroll
    for (int j = 0; j < 4; ++j) { const int n = (lane >> 3) + 8 * j; const LAS float* s = scr + (16 * c) * 33 + n;
        v4u o; o.x = pg8::pk4_fp8(s[0 * 33], s[1 * 33], s[2 * 33], s[3 * 33]); o.y = pg8::pk4_fp8(s[4 * 33], s[5 * 33], s[6 * 33], s[7 * 33]);
        o.z = pg8::pk4_fp8(s[8 * 33], s[9 * 33], s[10 * 33], s[11 * 33]); o.w = pg8::pk4_fp8(s[12 * 33], s[13 * 33], s[14 * 33], s[15 * 33]);
        *(GAS v4u*)(WT + (size_t)(r0 + n) * K + k0 + 16 * c) = o; }
    LDS_WAIT(); asm volatile("" ::: "memory");
}
constexpr int CVT_IW = 2816, CVT_IO = 1024, CVT8_IW = 2816, CVT_NMOE = 24 * CVT8_IW;
DI void cvt_moe_item(const Frame& F, int r, LAS float* scr) {
    const int mi = r / CVT8_IW, e = mi / 3, k = mi % 3; r -= mi * CVT8_IW;
    const float sc = pg8::f8_scale(((const unsigned*)(F.a->ws + WS_CTL))[CW_AMAX + mi]);
    if (k == 0) cvt8_item(F.a->in[I_M1] + (size_t)e * DM * DFF, DM, DFF, FW(unsigned char, WS_WM13) + (size_t)e * 2 * DFF * DM, 1, scr, r, F.lane, sc);
    else if (k == 1) cvt8_item(F.a->in[I_M3] + (size_t)e * DM * DFF, DM, DFF, FW(unsigned char, WS_WM13) + (size_t)e * 2 * DFF * DM, 2, scr, r, F.lane, sc);
    else cvt8_item(F.a->in[I_M2] + (size_t)e * DFF * DM, DFF, DM, FW(unsigned char, WS_WM2) + (size_t)e * DM * DFF, 0, scr, r, F.lane, sc);
}
DI void ph_cvt(const Frame& F0, int moe_hi) { const Frame F = launder(F0);
    for (int i = F.bx * NTHR + F.tid; i < 49152; i += F.G * NTHR) { const int l = i / 24576, r = i % 24576, s = r / 12288, j = r % 12288; float sum = F.a->in[I_ADAB][l * 12288 + j];
        for (int ks = 0; ks < 16; ++ks) sum += FW(float, WS_PART)[((size_t)(l * 16 + ks) * 2 + s) * 12288 + j];
        FW(float, WS_MODS)[i] = sum; }
    LAS float* scr = (LAS float*)(F.lds + F.wave * 17408);
    const int gw = F.bx * NWAVES + F.wave, NGW = F.G * NWAVES;
    constexpr int IW = CVT_IW, IO = CVT_IO; const int NIT = 2 * (IW + IO) + 3 * IW + moe_hi;
    for (int it = gw; it < NIT; it += NGW) {
        int r = NIT - 1 - it;
        if (r < IW) { cvt_item(F.a->in[I_WIN], DM, INC, FW(bf16, WS_WIN), 0, scr, r, F.lane); continue; } r -= IW;
        if (r < IO) { cvt_item(F.a->in[I_WOUT], DM, DM, FW(bf16, WS_WOUT), 0, scr, r, F.lane); continue; } r -= IO;
        if (r < IW) { cvt_item(F.a->in[I_F1], DM, DFF, FW(bf16, WS_WF13), 1, scr, r, F.lane); continue; } r -= IW;
        if (r < IW) { cvt_item(F.a->in[I_F3], DM, DFF, FW(bf16, WS_WF13), 2, scr, r, F.lane); continue; } r -= IW;
        if (r < IW) { cvt_item(F.a->in[I_F2], DFF, DM, FW(bf16, WS_WF2), 0, scr, r, F.lane); continue; } r -= IW;
        if (r < IW) { cvt_item(F.a->in[I_WIN] + (size_t)DM * INC, DM, INC, FW(bf16, WS_WIN) + (size_t)INC * DM, 0, scr, r, F.lane); continue; } r -= IW;
        if (r < IO) { cvt_item(F.a->in[I_WOUT] + (size_t)DM * DM, DM, DM, FW(bf16, WS_WOUT) + (size_t)DM * DM, 0, scr, r, F.lane); continue; } r -= IO;
        if (r < moe_hi) cvt_moe_item(F, r, scr);
    }
    __syncthreads();
}
DI void cvt_moe_range(const Frame& F0, int lo, int hi, int wv, int nw) { const Frame F = launder(F0);
    LAS float* scr = (LAS float*)(F.lds + F.wave * 17408);
    for (int r = lo + wv; r < hi; r += nw) cvt_moe_item(F, r, scr);
    __syncthreads();
}

DI void ph_norm(const Frame& F0, int l, int which, int nrb, bool route) { const Frame F = launder(F0);
    LAS float* vA = (LAS float*)F.lds;
    LAS float* rwT = (LAS float*)(F.lds + 32768);
    LAS int* hist = (LAS int*)(F.lds + SCR_OFF);
    const float* g = F.a->in[which ? I_N2G : I_N1G] + l * DM;
    const float* md = FW(float, WS_MODS) + (size_t)l * 24576;
    for (int i = F.tid; i < 4096; i += NTHR) { const int s = i >> 11, d = i & 2047; const float sh = md[s * 12288 + (which * 3) * 2048 + d], scl = md[s * 12288 + (which * 3 + 1) * 2048 + d];
        vA[i] = g[d] * (1.f + scl); vA[4096 + i] = sh; }
    if (route) for (int i = F.tid; i < 4096; i += NTHR) { const int d = i >> 1, hh = i & 1; const f32x4 v = *(const f32x4*)(F.a->in[I_RW] + d * 8 + hh * 4);
        rwT[(hh * 4 + 0) * 2048 + d] = v.x; rwT[(hh * 4 + 1) * 2048 + d] = v.y; rwT[(hh * 4 + 2) * 2048 + d] = v.z; rwT[(hh * 4 + 3) * 2048 + d] = v.w; }
    __syncthreads();
    const bool first = (l == 0 && which == 0);
    const float* xc = (l == 0) ? F.a->in[I_CTX] : FW(float, WS_XCTX);
    v4u* SEL = (v4u*)(F.a->ws + WS_SEL); int* RBCNT = (int*)(F.a->ws + WS_RBCNT);
    const bool spread = (F.G == 256 && nrb == NROW / 64);
    for (int rb = F.bx; rb < (spread ? SEQ / 64 : nrb); rb += F.G) {
        if (route) { if (F.tid < 8) hist[F.tid] = 0; __syncthreads(); }
        for (int i = 0; i < (spread ? 9 : 8); ++i) {
            if (i == 8 && F.wave != 0) break;
            const int r = i == 8 ? SEQ + F.bx : rb * 64 + F.wave * 8 + i; const int s = r >= SEQ ? 1 : 0;
            f32x4 v[8]; float ss = 0.f;
            if (s || first) { const GAS f32x4* xr = (const GAS f32x4*)(s ? xc + (size_t)(r - SEQ) * DM : F.a->in[I_X] + (size_t)r * DM) + F.lane;
#pragma unroll
                for (int j = 0; j < 8; ++j) v[j] = xr[64 * j]; }
            else { const GAS v2u* xr = (const GAS v2u*)(FW(bf16, WS_XB) + (size_t)r * DM) + F.lane;
#pragma unroll
                for (int j = 0; j < 8; ++j) { const v2u w = xr[64 * j]; v[j] = (f32x4){bflo(w.x), bfhi(w.x), bflo(w.y), bfhi(w.y)}; } }
            if (s && l == 0 && which == 1) {
                const float* gt = md + 12288 + 2 * 2048; GAS f32x4* xw = (GAS f32x4*)(FW(float, WS_XCTX) + (size_t)(r - SEQ) * DM) + F.lane;
#pragma unroll
                for (int j = 0; j < 8; ++j) { f32x4 a = (f32x4){0.f, 0.f, 0.f, 0.f};
                    for (int sl = 0; sl < 8; ++sl) a += *((const GAS f32x4*)(FW(float, WS_PC1) + ((size_t)sl * 256 + (r - SEQ)) * DM) + F.lane + 64 * j);
                    v[j] = v[j] + *(const f32x4*)(gt + 4 * F.lane + 256 * j) * a; xw[64 * j] = v[j]; } }
            if (s && l == 1 && which == 0) {
                const float* gt = FW(float, WS_MODS) + 12288 + 5 * 2048;
#pragma unroll
                for (int j = 0; j < 8; ++j) { f32x4 a = (f32x4){0.f, 0.f, 0.f, 0.f};
                    for (int sl = 0; sl < 11; ++sl) a += *((const GAS f32x4*)(FW(float, WS_PC2) + ((size_t)sl * 256 + (r - SEQ)) * DM) + F.lane + 64 * j);
                    v[j] = v[j] + *(const f32x4*)(gt + 4 * F.lane + 256 * j) * a; } }
#pragma unroll
            for (int j = 0; j < 8; ++j) ss += (v[j].x * v[j].x + v[j].y * v[j].y) + (v[j].z * v[j].z + v[j].w * v[j].w);
            const float rstd = 1.f / sqrtf(wave_sum(ss) * (1.f / DM) + EPS);
            GAS v2u* o = (GAS v2u*)(FW(bf16, WS_H) + (size_t)r * DM) + F.lane; GAS unsigned* o8 = (GAS unsigned*)(FW(unsigned char, WS_H) + (size_t)r * DM) + F.lane;
#pragma unroll
            for (int j = 0; j < 8; ++j) { const f32x4 a = *(const LAS f32x4*)(vA + s * 2048 + 4 * F.lane + 256 * j), b = *(const LAS f32x4*)(vA + 4096 + s * 2048 + 4 * F.lane + 256 * j);
                v[j] = v[j] * rstd * a + b;
                if (route) o8[64 * j] = pg8::pk4_fp8(v[j].x * F8_SH, v[j].y * F8_SH, v[j].z * F8_SH, v[j].w * F8_SH);
                else { v2u w; w.x = pk2(v[j].x, v[j].y); w.y = pk2(v[j].z, v[j].w); o[64 * j] = w; } }
            if (route) {
                float lg[8];
#pragma unroll
                for (int e = 0; e < 8; ++e) { float t = 0.f;
#pragma unroll
                    for (int j = 0; j < 8; ++j) { const f32x4 w = *(const LAS f32x4*)(rwT + e * 2048 + 4 * F.lane + 256 * j); t += (v[j].x * w.x + v[j].y * w.y) + (v[j].z * w.z + v[j].w * w.w); }
                    lg[e] = wave_sum(t) + F.a->in[I_RB][e]; }
                int e0 = 0; float v0 = lg[0];
#pragma unroll
                for (int e = 1; e < 8; ++e) if (lg[e] > v0) { v0 = lg[e]; e0 = e; }
                int e1 = -1; float v1 = -3.0e38f;
#pragma unroll
                for (int e = 0; e < 8; ++e) if (e != e0 && lg[e] > v1) { v1 = lg[e]; e1 = e; }
                if (e1 < 0) { e1 = (e0 + 1) & 7; v1 = v0; }
                const float g0 = 1.f / (1.f + expf(v1 - v0)), g1 = 1.f - g0;
                if (F.lane == 0) { v4u sv; sv.x = (unsigned)e0 | ((unsigned)e1 << 8); sv.y = __float_as_uint(g0); sv.z = __float_as_uint(g1); sv.w = 0u; SEL[r] = sv;
                    __hip_atomic_fetch_add(hist + e0, 1, __ATOMIC_RELAXED, __HIP_MEMORY_SCOPE_WORKGROUP); __hip_atomic_fetch_add(hist + e1, 1, __ATOMIC_RELAXED, __HIP_MEMORY_SCOPE_WORKGROUP); }
            }
        }
        if (route) { __syncthreads(); if (F.tid < 8) RBCNT[rb * 8 + F.tid] = hist[F.tid]; __syncthreads(); }
    }
    __syncthreads();
}


DI void unpk8(const v4u w, float (&v)[8]) { v[0] = bflo(w.x); v[1] = bfhi(w.x); v[2] = bflo(w.y); v[3] = bfhi(w.y); v[4] = bflo(w.z); v[5] = bfhi(w.z); v[6] = bflo(w.w); v[7] = bfhi(w.w); }
DI v4u pk8(const float (&v)[8]) { v4u w; w.x = pk2(v[0], v[1]); w.y = pk2(v[2], v[3]); w.z = pk2(v[4], v[5]); w.w = pk2(v[6], v[7]); return w; }
DI void rope8(float (&x1)[8], float (&x2)[8], const float* tab) {
    const f32x4 c0 = *(const GAS f32x4*)tab, c1 = *(const GAS f32x4*)(tab + 4), s0 = *(const GAS f32x4*)(tab + 8192), s1 = *(const GAS f32x4*)(tab + 8196);
    const float cs[8] = {c0.x, c0.y, c0.z, c0.w, c1.x, c1.y, c1.z, c1.w}, sn[8] = {s0.x, s0.y, s0.z, s0.w, s1.x, s1.y, s1.z, s1.w};
#pragma unroll
    for (int i = 0; i < 8; ++i) { const float a = x1[i], b = x2[i]; x1[i] = a * cs[i] - b * sn[i]; x2[i] = b * cs[i] + a * sn[i]; }
}

DI int tokp(int tok) { return (tok & ~31) | (((tok >> 2) & 3) << 3) | (((tok >> 4) & 1) << 2) | (tok & 3); }
DI void prep_src(int it, int& blk, int& kind, int& h, int& cb) {
    blk = it >> 2; const int hs = it & 3;
    if (hs < 2) { kind = 1; h = hs; cb = C_KA; } else { kind = 2; h = hs - 2; cb = C_VA; }
    cb += h * 128;
}
DI void ph_prep(const Frame& F0, int l) { const Frame F = launder(F0);
    LAS unsigned char* T = F.lds;
    const int t = F.tid, tok = t >> 2, q = t & 3;
    const float* kg = F.a->in[I_KG] + l * HD;
    f32x4 kgv[4][2];
#pragma unroll
    for (int c = 0; c < 4; ++c) { kgv[c][0] = *(const f32x4*)(kg + 32 * c + 8 * q); kgv[c][1] = *(const f32x4*)(kg + 32 * c + 8 * q + 4); }
    const int NIT = NBLK * 4;
    v4u cur[4];
    { int blk, kind, h, cb; if (F.bx < NIT) { prep_src(F.bx, blk, kind, h, cb); const bf16* rp = FW(bf16, WS_PROJ) + (size_t)(blk * 128 + tok) * INC + cb + 8 * q;
#pragma unroll
        for (int c = 0; c < 4; ++c) cur[c] = *(const GAS v4u*)(rp + 32 * c); } }
    for (int it = F.bx; it < NIT; it += F.G) {
        int blk, kind, h, cb; prep_src(it, blk, kind, h, cb); const bool lat = blk < 128;
        const int row = blk * 128 + tok;
        bf16* rp = FW(bf16, WS_PROJ) + (size_t)row * INC + cb + 8 * q;
        v4u nxt[4];
        if (it + F.G < NIT) { int b2, k2, h2, c2; prep_src(it + F.G, b2, k2, h2, c2); const bf16* rp2 = FW(bf16, WS_PROJ) + (size_t)(b2 * 128 + tok) * INC + c2 + 8 * q;
#pragma unroll
            for (int c = 0; c < 4; ++c) nxt[c] = *(const GAS v4u*)(rp2 + 32 * c); }
        v4u w[4];
        if (kind == 1) {
            float v[4][8];
#pragma unroll
            for (int c = 0; c < 4; ++c) unpk8(cur[c], v[c]);
            {
                float ss = 0.f;
#pragma unroll
                for (int c = 0; c < 4; ++c)
#pragma unroll
                    for (int i = 0; i < 8; ++i) ss += v[c][i] * v[c][i];
                ss += __shfl_xor(ss, 1); ss += __shfl_xor(ss, 2);
                const float rstd = 1.f / sqrtf(ss * (1.f / HD) + EPS);
#pragma unroll
                for (int c = 0; c < 4; ++c) { const float gg[8] = {kgv[c][0].x, kgv[c][0].y, kgv[c][0].z, kgv[c][0].w, kgv[c][1].x, kgv[c][1].y, kgv[c][1].z, kgv[c][1].w};
#pragma unroll
                    for (int i = 0; i < 8; ++i) v[c][i] *= rstd * gg[i]; }
            }
            if (lat) { rope8(v[0], v[1], FW(float, WS_ROPE) + (row >> 6) * 32 + 8 * q); rope8(v[2], v[3], FW(float, WS_ROPE) + (row & 63) * 32 + 8 * q); }
#pragma unroll
            for (int c = 0; c < 4; ++c) { w[c] = pk8(v[c]); *(GAS v4u*)(rp + 32 * c) = w[c]; }
        } else {
#pragma unroll
            for (int c = 0; c < 4; ++c) w[c] = cur[c];
        }
        if (kind != 1) {
#pragma unroll
            for (int c = 0; c < 4; ++c) { const unsigned ww[4] = {w[c].x, w[c].y, w[c].z, w[c].w};
#pragma unroll
                for (int i = 0; i < 8; ++i) *(LAS bf16*)(T + (32 * c + 8 * q + i) * 272 + tokp(tok) * 2) = (bf16)((i & 1) ? (ww[i >> 1] >> 16) : (ww[i >> 1] & 0xffffu)); }
            __syncthreads();
            bf16* dst = FW(bf16, WS_VAT) + (size_t)(blk * 2 + h) * 16384;
#pragma unroll
            for (int k = 0; k < 4; ++k) { const int id = t + 512 * k, d = id >> 4, tc = id & 15; const v4u x = *(const LAS v4u*)(T + d * 272 + tc * 16); *(GAS v4u*)(dst + d * 128 + tc * 8) = x; }
            __syncthreads();
        }
#pragma unroll
        for (int c = 0; c < 4; ++c) cur[c] = nxt[c];
    }
    __syncthreads();
}

DI int attn_tile_blk(int b, int ti) { return ti < 2 ? 128 + ti : b - 1 + (ti - 2); }
DI bool attn_tile_valid(int b, int ti) { if (ti < 2) return true; const int kb = b - 1 + (ti - 2); return kb >= 0 && kb < 128; }
DI void attn_load(const Frame& F, int b, int kvh, int ti, v4u (&kr)[4], v4u (&vr)[4]) {
    const int kb = attn_tile_blk(b, ti);
#pragma unroll
    for (int i = 0; i < 4; ++i) { const int id = F.tid + 512 * i, key = id >> 4, dc = id & 15; kr[i] = *(const GAS v4u*)(FW(bf16, WS_PROJ) + (size_t)(kb * 128 + key) * INC + C_KA + kvh * 128 + dc * 8); }
#pragma unroll
    for (int i = 0; i < 4; ++i) { const int id = F.tid + 512 * i, d = id >> 4, kc = id & 15; vr[i] = *(const GAS v4u*)(FW(bf16, WS_VAT) + ((size_t)(kb * 2 + kvh) * 128 + d) * 128 + kc * 8); }
}
DI void attn_item(const Frame& F0, int l, int b, int kvh, int pair, float m2) { const Frame F = launder(F0);
    const int w = F.wave, lane = F.lane, fr = lane & 15, fq = lane >> 4;
    LAS unsigned char* Ks = F.lds; LAS unsigned char* Vs = F.lds + 34816;
    const int head = kvh * 4 + pair * 2 + (w >> 2);
    const int qrow0 = b * 128 + (w & 3) * 32;
    bf16x8 Q[2][4];
    const float c1 = 0.08838834764831845f * 1.44269504089f;
    { const float* qg = F.a->in[I_QG] + l * HD;
#pragma unroll
      for (int qt = 0; qt < 2; ++qt) { const int row = qrow0 + qt * 16 + fr; float v[4][8]; float ss = 0.f;
#pragma unroll
        for (int ks = 0; ks < 4; ++ks) { unpk8(*(const GAS v4u*)(FW(bf16, WS_PROJ) + (size_t)row * INC + C_QA + head * 128 + ks * 32 + fq * 8), v[ks]);
#pragma unroll
            for (int i = 0; i < 8; ++i) ss += v[ks][i] * v[ks][i]; }
        ss += __shfl_xor(ss, 16); ss += __shfl_xor(ss, 32);
        const float rs = c1 / sqrtf(ss * (1.f / HD) + EPS);
#pragma unroll
        for (int ks = 0; ks < 4; ++ks) { const f32x4 g0 = *(const f32x4*)(qg + ks * 32 + fq * 8), g1 = *(const f32x4*)(qg + ks * 32 + fq * 8 + 4); const float gg[8] = {g0.x, g0.y, g0.z, g0.w, g1.x, g1.y, g1.z, g1.w};
#pragma unroll
            for (int i = 0; i < 8; ++i) v[ks][i] *= rs * gg[i]; }
        if (b < 128) { rope8(v[0], v[1], FW(float, WS_ROPE) + (row >> 6) * 32 + 8 * fq); rope8(v[2], v[3], FW(float, WS_ROPE) + (row & 63) * 32 + 8 * fq); }
#pragma unroll
        for (int ks = 0; ks < 4; ++ks) Q[qt][ks] = __builtin_bit_cast(bf16x8, pk8(v[ks])); } }
    f32x4 O[8][2];
#pragma unroll
    for (int dt = 0; dt < 8; ++dt) { O[dt][0] = (f32x4){0.f, 0.f, 0.f, 0.f}; O[dt][1] = O[dt][0]; }
    float ls[2] = {0.f, 0.f};
    const int nt = b >= 128 ? 2 : 5;
    v4u kr[4], vr[4];
    if (w & 1) __builtin_amdgcn_s_setprio(2);
    int ti = 0; attn_load(F, b, kvh, 0, kr, vr);
    for (;;) {
#pragma unroll
        for (int i = 0; i < 4; ++i) { const int id = F.tid + 512 * i; const int lo = (id >> 4) * 272 + (id & 15) * 16; *(LAS v4u*)(Ks + lo) = kr[i]; *(LAS v4u*)(Vs + lo) = vr[i]; }
        int nx = ti + 1; while (nx < nt && !attn_tile_valid(b, nx)) ++nx;
        __syncthreads();
        if (nx < nt) attn_load(F, b, kvh, nx, kr, vr);
        const int kstart = attn_tile_blk(b, ti) * 128;
        const bool edge = ti == 2 || ti == 4;
#pragma nounroll
        for (int hf = 0; hf < 2; ++hf) {
            f32x4 S[4][2];
#pragma unroll
            for (int kt = 0; kt < 4; ++kt) { S[kt][0] = (f32x4){-m2, -m2, -m2, -m2}; S[kt][1] = S[kt][0]; }
#pragma unroll
            for (int ks = 0; ks < 4; ++ks)
#pragma unroll
                for (int kt = 0; kt < 4; ++kt) { const bf16x8 kf = *(const LAS bf16x8*)(Ks + (64 * hf + 16 * kt + fr) * 272 + ks * 64 + fq * 16);
                    S[kt][0] = MFMA16(kf, Q[0][ks], S[kt][0]); S[kt][1] = MFMA16(kf, Q[1][ks], S[kt][1]); }
            if (edge) {
#pragma unroll
                for (int qt = 0; qt < 2; ++qt) { const int qpos = qrow0 + qt * 16 + fr;
#pragma unroll
                    for (int kt = 0; kt < 4; ++kt)
#pragma unroll
                        for (int rg = 0; rg < 4; ++rg) { float p = ex2(S[kt][qt][rg]); const int dd = qpos - (kstart + 64 * hf + 16 * kt + 4 * fq + rg); if (dd > 128 || dd < -128) p = 0.f; S[kt][qt][rg] = p; ls[qt] += p; } }
            } else {
#pragma unroll
                for (int qt = 0; qt < 2; ++qt)
#pragma unroll
                    for (int kt = 0; kt < 4; ++kt)
#pragma unroll
                        for (int rg = 0; rg < 4; ++rg) { const float p = ex2(S[kt][qt][rg]); S[kt][qt][rg] = p; ls[qt] += p; }
            }
            bf16x8 P[2][2];
#pragma unroll
            for (int qt = 0; qt < 2; ++qt)
#pragma unroll
                for (int s2 = 0; s2 < 2; ++s2) { v4u pw; pw.x = pk2(S[2 * s2][qt][0], S[2 * s2][qt][1]); pw.y = pk2(S[2 * s2][qt][2], S[2 * s2][qt][3]);
                    pw.z = pk2(S[2 * s2 + 1][qt][0], S[2 * s2 + 1][qt][1]); pw.w = pk2(S[2 * s2 + 1][qt][2], S[2 * s2 + 1][qt][3]); P[qt][s2] = __builtin_bit_cast(bf16x8, pw); }
#pragma unroll
            for (int s2 = 0; s2 < 2; ++s2)
#pragma unroll
                for (int dt = 0; dt < 8; ++dt) { const bf16x8 vf = *(const LAS bf16x8*)(Vs + (16 * dt + fr) * 272 + (64 * hf + 32 * s2 + 8 * fq) * 2);
                    O[dt][0] = MFMA16(vf, P[0][s2], O[dt][0]); O[dt][1] = MFMA16(vf, P[1][s2], O[dt][1]); }
        }
        __syncthreads();
        if (nx >= nt) break;
        ti = nx;
    }
    __builtin_amdgcn_s_setprio(0);
    const float sk = F.a->in[I_SINK][l * 8 + head];
#pragma unroll
    for (int qt = 0; qt < 2; ++qt) { float s = ls[qt]; s += __shfl_xor(s, 16); s += __shfl_xor(s, 32); const float inv = 1.f / (s + ex2(sk * 1.44269504089f - m2));
        bf16* op = FW(bf16, WS_MIX) + (size_t)(qrow0 + qt * 16 + fr) * DM + head * 128 + 4 * fq;
#pragma unroll
        for (int dt = 0; dt < 8; ++dt) { const f32x4 o = O[dt][qt] * inv; v2u wv; wv.x = pk2(o.x, o.y); wv.y = pk2(o.z, o.w); *(GAS v2u*)(op + 16 * dt) = wv; } }
}

DI void fkv_load(const Frame& F, int it, v4u (&kc)[4], v4u (&vc)[4]) {
    const int cz = it >> 3, h = it & 7, tok = F.tid >> 2, q = F.tid & 3; const bf16* rp = FW(bf16, WS_PROJ) + (size_t)(cz * 128 + tok) * INC + h * 128 + 8 * q;
#pragma unroll
    for (int c = 0; c < 4; ++c) { kc[c] = *(const GAS v4u*)(rp + C_KR + 32 * c); vc[c] = *(const GAS v4u*)(rp + C_VR + 32 * c); }
}
DI void fkv_item(const Frame& F0, int cz, int h, float lgf2, float lgb2, int nxt, v4u (&kc)[4], v4u (&vc)[4]) { const Frame F = launder(F0);
    const int w = F.wave, lane = F.lane, fr = lane & 15, fq = lane >> 4, t = F.tid, tok = t >> 2, q = t & 3;
    LAS unsigned char* T1 = F.lds; LAS unsigned char* T2 = F.lds + 34816;
    const int row = cz * 128 + tok;
    { float v[4][8];
#pragma unroll
      for (int c = 0; c < 4; ++c) unpk8(kc[c], v[c]);
      if (cz < 128) { rope8(v[0], v[1], FW(float, WS_ROPE) + (row >> 6) * 32 + 8 * q); rope8(v[2], v[3], FW(float, WS_ROPE) + (row & 63) * 32 + 8 * q); }
      bf16* rp = FW(bf16, WS_PROJ) + (size_t)row * INC + C_KR + h * 128 + 8 * q;
#pragma unroll
      for (int c = 0; c < 4; ++c) {
#pragma unroll
          for (int i = 0; i < 8; ++i) v[c][i] *= 0.08838834764831845f;
          const v4u kw = pk8(v[c]); *(GAS v4u*)(rp + 32 * c) = kw;
          const unsigned k4[4] = {kw.x, kw.y, kw.z, kw.w}, v4[4] = {vc[c].x, vc[c].y, vc[c].z, vc[c].w};
#pragma unroll
          for (int i = 0; i < 8; ++i) { const int d = 32 * c + 8 * q + i;
              *(LAS bf16*)(T1 + d * 272 + tokp(tok) * 2) = (bf16)((i & 1) ? (k4[i >> 1] >> 16) : (k4[i >> 1] & 0xffffu));
              *(LAS bf16*)(T2 + d * 272 + tokp(tok) * 2) = (bf16)((i & 1) ? (v4[i >> 1] >> 16) : (v4[i >> 1] & 0xffffu)); } } }
    __syncthreads();
    if (nxt >= 0) fkv_load(F, nxt, kc, vc);
    { bf16* dst = FW(bf16, WS_VRT) + (size_t)(cz * 8 + h) * 16384;
#pragma unroll
      for (int k = 0; k < 4; ++k) { const int id = t + 512 * k, d = id >> 4, tc = id & 15; *(GAS v4u*)(dst + d * 128 + tc * 8) = *(const LAS v4u*)(T2 + d * 272 + tc * 16); } }
    bf16x8 Xf[4], Xb[4];
#pragma unroll
    for (int ks = 0; ks < 4; ++ks) { const v4u x = *(const LAS v4u*)(T2 + (16 * w + fr) * 272 + (32 * ks + 8 * fq) * 2); const unsigned xw[4] = {x.x, x.y, x.z, x.w}; v4u of, ob; unsigned rf[4], rb[4];
#pragma unroll
        for (int i = 0; i < 4; ++i) { const int j = 32 * ks + 16 * (i >> 1) + 4 * fq + 2 * (i & 1); const float a = bflo(xw[i]), b = bfhi(xw[i]);
            rf[i] = pk2(a * ex2((float)(127 - j) * lgf2), b * ex2((float)(126 - j) * lgf2)); rb[i] = pk2(a * ex2((float)j * lgb2), b * ex2((float)(j + 1) * lgb2)); }
        of.x = rf[0]; of.y = rf[1]; of.z = rf[2]; of.w = rf[3]; ob.x = rb[0]; ob.y = rb[1]; ob.z = rb[2]; ob.w = rb[3];
        Xf[ks] = __builtin_bit_cast(bf16x8, of); Xb[ks] = __builtin_bit_cast(bf16x8, ob); }
    f32x4 af[8], ab[8];
#pragma unroll
    for (int dt = 0; dt < 8; ++dt) { af[dt] = (f32x4){0.f, 0.f, 0.f, 0.f}; ab[dt] = af[dt]; }
#pragma unroll
    for (int ks = 0; ks < 4; ++ks)
#pragma unroll
        for (int dt = 0; dt < 8; ++dt) { const bf16x8 yf = *(const LAS bf16x8*)(T1 + (16 * dt + fr) * 272 + ks * 64 + fq * 16); af[dt] = MFMA16(yf, Xf[ks], af[dt]); ab[dt] = MFMA16(yf, Xb[ks], ab[dt]); }
    bf16* o = FW(bf16, WS_KV) + ((size_t)((cz * 8 + h) * 2) * 128 + 16 * w + fr) * 128 + 4 * fq;
#pragma unroll
    for (int dt = 0; dt < 8; ++dt) { v2u a, b; a.x = pk2_safe(af[dt].x, af[dt].y); a.y = pk2_safe(af[dt].z, af[dt].w); b.x = pk2_safe(ab[dt].x, ab[dt].y); b.y = pk2_safe(ab[dt].z, ab[dt].w);
        *(GAS v2u*)(o + 16 * dt) = a; *(GAS v2u*)(o + 16384 + 16 * dt) = b; }
    __syncthreads();
}
DI float log2_gamma(const Frame& F, int l, int dir, int h) { const float x = F.a->in[I_DECAY][(l * 2 + dir) * 8 + h]; return -log1pf(expf(-x)) * 1.44269504089f; }

DI void ph_prep_kv(const Frame& F0, int l) { const Frame F = launder(F0);
    ph_prep(F0, l);
    const int NKV = NBLK * 8;
    v4u kc[4], vc[4];
    int it = F.G - 1 - F.bx;
    if (it < NKV) fkv_load(F, it, kc, vc);
    for (; it < NKV; it += F.G) { const int cz = it >> 3, h = it & 7; fkv_item(F0, cz, h, log2_gamma(F, l, 0, h), log2_gamma(F, l, 1, h), it + F.G < NKV ? it + F.G : -1, kc, vc); }
    __syncthreads();
}

DI void scan_share(const Frame& F0, int l, int s, int SG) { const Frame F = launder(F0);
    for (int idx = s * NTHR + F.tid; idx < 131072; idx += 2 * SG * NTHR) {
        const int idx2 = idx + SG * NTHR; const bool two = idx2 < 131072; const int jdx = two ? idx2 : idx;
        const int h = idx >> 14, dir = (idx >> 13) & 1, h2 = jdx >> 14, dir2 = (jdx >> 13) & 1;
        const float dec = ex2(128.f * log2_gamma(F, l, dir, h)), dec2 = ex2(128.f * log2_gamma(F, l, dir2, h2));
        const size_t base = ((size_t)(h * 2 + dir) * 128 + ((idx >> 6) & 127)) * 128 + (idx & 63) * 2, base2 = ((size_t)(h2 * 2 + dir2) * 128 + ((jdx >> 6) & 127)) * 128 + (jdx & 63) * 2;
        float s0 = 0.f, s1 = 0.f, t0 = 0.f, t1 = 0.f;
        for (int st = 0; st < 130; st += 10) {
            unsigned kv[10], kw[10];
#pragma unroll
            for (int u = 0; u < 10; ++u) { const int step = st + u; const int cz = dir ? 129 - step : (step < 2 ? 128 + step : step - 2), cz2 = dir2 ? 129 - step : (step < 2 ? 128 + step : step - 2);
                kv[u] = *(const GAS unsigned*)(FW(bf16, WS_KV) + (size_t)cz * 262144 + base); kw[u] = *(const GAS unsigned*)(FW(bf16, WS_KV) + (size_t)cz2 * 262144 + base2); }
#pragma unroll
            for (int u = 0; u < 10; ++u) { const int step = st + u; const int cz = dir ? 129 - step : (step < 2 ? 128 + step : step - 2), cz2 = dir2 ? 129 - step : (step < 2 ? 128 + step : step - 2);
                *(GAS unsigned*)(FW(bf16, WS_SPREV) + (size_t)cz * 262144 + base) = pk2(s0, s1); s0 = dec * s0 + bflo(kv[u]); s1 = dec * s1 + bfhi(kv[u]);
                if (two) { *(GAS unsigned*)(FW(bf16, WS_SPREV) + (size_t)cz2 * 262144 + base2) = pk2(t0, t1); t0 = dec2 * t0 + bflo(kw[u]); t1 = dec2 * t1 + bfhi(kw[u]); } }
        }
    }
}

DI void ld_tile128(LAS unsigned char* dst, const bf16* src, int pitch_elems, int tid) {
#pragma unroll
    for (int k = 0; k < 4; ++k) { const int id = tid + 512 * k, r = id >> 4, c = id & 15; *(LAS v4u*)(dst + r * 272 + c * 16) = *(const GAS v4u*)(src + (size_t)r * pitch_elems + c * 8); }
}
DI void ret_ld_pair(const bf16* a, int pa, const bf16* b, int pb, int tid, v4u (&R)[8]) {
#pragma unroll
    for (int k = 0; k < 4; ++k) { const int id = tid + 512 * k, r = id >> 4, c = id & 15; R[k] = *(const GAS v4u*)(a + (size_t)r * pa + c * 8); R[4 + k] = *(const GAS v4u*)(b + (size_t)r * pb + c * 8); }
}
DI void ret_st_pair(LAS unsigned char* A, LAS unsigned char* B, int tid, const v4u (&R)[8]) {
#pragma unroll
    for (int k = 0; k < 4; ++k) { const int id = tid + 512 * k, r = id >> 4, c = id & 15; const int lo = r * 272 + c * 16; *(LAS v4u*)(A + lo) = R[k]; *(LAS v4u*)(B + lo) = R[4 + k]; }
}
DI void ret_ld_state(const Frame& F, int it, v4u (&R)[8]) { const int cz = it >> 3, h = it & 7; const bf16* s2 = FW(bf16, WS_SPREV) + (size_t)cz * 262144 + (size_t)(h * 2) * 16384; ret_ld_pair(s2, 128, s2 + 16384, 128, F.tid, R); }
DI void ret_ld_kv(const Frame& F, int it, v4u (&R)[8]) { const int cz = it >> 3, h = it & 7; ret_ld_pair(FW(bf16, WS_PROJ) + (size_t)(cz * 128) * INC + C_KR + h * 128, INC, FW(bf16, WS_VRT) + (size_t)(cz * 8 + h) * 16384, 128, F.tid, R); }
DI void ret_item(const Frame& F0, int l, int it, int nxt, v4u (&R)[8]) { const Frame F = launder(F0);
    const int w = F.wave, lane = F.lane, fr = lane & 15, fq = lane >> 4;
    LAS unsigned char* Kn = F.lds; LAS unsigned char* Vt = F.lds + 34816; LAS unsigned char* Sf = F.lds + 2 * 34816; LAS unsigned char* Sb = F.lds + 3 * 34816;
    const int cz = it >> 3, h = it & 7, row0 = cz * 128;
    const float lgf2 = log2_gamma(F, l, 0, h), lgb2 = log2_gamma(F, l, 1, h);
    const int i = 16 * w + fr;
    const bf16* qp = FW(bf16, WS_PROJ) + (size_t)(row0 + i) * INC;
    bf16x8 Qf[4];
    { v4u qw[4];
#pragma unroll
      for (int ks = 0; ks < 4; ++ks) qw[ks] = *(const GAS v4u*)(qp + C_QR + h * 128 + 32 * ks + 8 * fq);
      if (nxt >= 0) ret_ld_state(F, nxt, R);
      if (cz < 128) { float v[4][8];
#pragma unroll
        for (int ks = 0; ks < 4; ++ks) unpk8(qw[ks], v[ks]);
        const int row = row0 + i; rope8(v[0], v[1], FW(float, WS_ROPE) + (row >> 6) * 32 + 8 * fq); rope8(v[2], v[3], FW(float, WS_ROPE) + (row & 63) * 32 + 8 * fq);
#pragma unroll
        for (int ks = 0; ks < 4; ++ks) qw[ks] = pk8(v[ks]); }
#pragma unroll
      for (int ks = 0; ks < 4; ++ks) Qf[ks] = __builtin_bit_cast(bf16x8, qw[ks]); }
    f32x4 Y[8];
    { f32x4 CF[8], CB[8];
#pragma unroll
      for (int et = 0; et < 8; ++et) { CF[et] = (f32x4){0.f, 0.f, 0.f, 0.f}; CB[et] = CF[et]; }
#pragma unroll
      for (int ks = 0; ks < 4; ++ks) { bf16x8 sfv[8], sbv[8];
#pragma unroll
        for (int et = 0; et < 8; ++et) { sfv[et] = *(const LAS bf16x8*)(Sf + (16 * et + fr) * 272 + ks * 64 + fq * 16); sbv[et] = *(const LAS bf16x8*)(Sb + (16 * et + fr) * 272 + ks * 64 + fq * 16); }
        __builtin_amdgcn_sched_barrier(0);
#pragma unroll
        for (int et = 0; et < 8; ++et) { CF[et] = MFMA16(sfv[et], Qf[ks], CF[et]); CB[et] = MFMA16(sbv[et], Qf[ks], CB[et]); }
        __builtin_amdgcn_sched_barrier(0); }
      const float cf = ex2((float)(i + 1) * lgf2), cb = ex2((float)(128 - i) * lgb2);
#pragma unroll
      for (int et = 0; et < 8; ++et) Y[et] = cf * CF[et] + cb * CB[et];
    }
    __syncthreads();
    if (nxt >= 0) { ret_st_pair(Sf, Sb, F.tid, R); ret_ld_kv(F, nxt, R); }
    f32x4 S[8];
#pragma unroll
    for (int jt = 0; jt < 8; ++jt) S[jt] = (f32x4){0.f, 0.f, 0.f, 0.f};
#pragma unroll
    for (int ks = 0; ks < 4; ks += 2) { bf16x8 kfv[2][8];
#pragma unroll
        for (int k2 = 0; k2 < 2; ++k2)
#pragma unroll
            for (int jt = 0; jt < 8; ++jt) kfv[k2][jt] = *(const LAS bf16x8*)(Kn + (16 * jt + fr) * 272 + (ks + k2) * 64 + fq * 16);
        __builtin_amdgcn_sched_barrier(0);
#pragma unroll
        for (int k2 = 0; k2 < 2; ++k2)
#pragma unroll
            for (int jt = 0; jt < 8; ++jt) S[jt] = MFMA16(kfv[k2][jt], Qf[ks + k2], S[jt]);
        __builtin_amdgcn_sched_barrier(0); }
#pragma unroll
    for (int jt = 0; jt < 8; ++jt)
#pragma unroll
        for (int rg = 0; rg < 4; ++rg) { const int dl = i - (16 * jt + 4 * fq + rg); const float wgt = dl > 0 ? ex2((float)dl * lgf2) : (dl < 0 ? ex2((float)(-dl) * lgb2) : 2.f); S[jt][rg] *= wgt; }
    bf16x8 P[4];
#pragma unroll
    for (int s4 = 0; s4 < 4; ++s4) { v4u pw; pw.x = pk2(S[2 * s4][0], S[2 * s4][1]); pw.y = pk2(S[2 * s4][2], S[2 * s4][3]); pw.z = pk2(S[2 * s4 + 1][0], S[2 * s4 + 1][1]); pw.w = pk2(S[2 * s4 + 1][2], S[2 * s4 + 1][3]);
        P[s4] = __builtin_bit_cast(bf16x8, pw); }
#pragma unroll
    for (int s4 = 0; s4 < 4; s4 += 2) { bf16x8 vfv[2][8];
#pragma unroll
        for (int k2 = 0; k2 < 2; ++k2)
#pragma unroll
            for (int et = 0; et < 8; ++et) vfv[k2][et] = *(const LAS bf16x8*)(Vt + (16 * et + fr) * 272 + (32 * (s4 + k2) + 8 * fq) * 2);
        __builtin_amdgcn_sched_barrier(0);
#pragma unroll
        for (int k2 = 0; k2 < 2; ++k2)
#pragma unroll
            for (int et = 0; et < 8; ++et) Y[et] = MFMA16(vfv[k2][et], P[s4 + k2], Y[et]);
        __builtin_amdgcn_sched_barrier(0); }
    float sum = 0.f;
#pragma unroll
    for (int et = 0; et < 8; ++et) sum += (Y[et].x + Y[et].y) + (Y[et].z + Y[et].w);
    sum += __shfl_xor(sum, 16); sum += __shfl_xor(sum, 32);
    const float mu = sum * (1.f / HD); float var = 0.f;
#pragma unroll
    for (int et = 0; et < 8; ++et) { Y[et] = Y[et] - mu; var += (Y[et].x * Y[et].x + Y[et].y * Y[et].y) + (Y[et].z * Y[et].z + Y[et].w * Y[et].w); }
    var += __shfl_xor(var, 16); var += __shfl_xor(var, 32);
    const float rstd = 1.f / sqrtf(var * (1.f / HD) + EPS);
    const float* gn = F.a->in[I_GNG] + (size_t)(l * 8 + h) * HD + 4 * fq;
    bf16* op = FW(bf16, WS_MIX) + (size_t)(row0 + i) * DM + 1024 + h * 128 + 4 * fq;
    v2u gwv[8]; f32x4 ggv[8];
#pragma unroll
    for (int et = 0; et < 8; ++et) { gwv[et] = *(const GAS v2u*)(qp + C_GR + h * 128 + 16 * et + 4 * fq); ggv[et] = *(const GAS f32x4*)(gn + 16 * et); }
#pragma unroll
    for (int et = 0; et < 8; ++et) { const v2u gw = gwv[et]; const f32x4 gg = ggv[et];
        const float g0 = bflo(gw.x), g1 = bfhi(gw.x), g2 = bflo(gw.y), g3 = bfhi(gw.y);
        const float o0 = g0 * __builtin_amdgcn_rcpf(1.f + ex2(-1.44269504089f * g0)) * (Y[et].x * rstd * gg.x), o1 = g1 * __builtin_amdgcn_rcpf(1.f + ex2(-1.44269504089f * g1)) * (Y[et].y * rstd * gg.y);
        const float o2 = g2 * __builtin_amdgcn_rcpf(1.f + ex2(-1.44269504089f * g2)) * (Y[et].z * rstd * gg.z), o3 = g3 * __builtin_amdgcn_rcpf(1.f + ex2(-1.44269504089f * g3)) * (Y[et].w * rstd * gg.w);
        v2u wv; wv.x = pk2(o0, o1); wv.y = pk2(o2, o3); *(GAS v2u*)(op + 16 * et) = wv; }
    __syncthreads();
    if (nxt >= 0) ret_st_pair(Kn, Vt, F.tid, R);
    __syncthreads();
}
DI void ret_ctx_item(const Frame& F0, int l, int it) { const Frame F = launder(F0);
    LAS unsigned char* Kn = F.lds; LAS unsigned char* Vt = F.lds + 34816; LAS unsigned char* Sf = F.lds + 2 * 34816; LAS unsigned char* Sb = F.lds + 3 * 34816;
    const int cz = it >> 3, h = it & 7; v4u R[8];
    const bf16* zero = FW(bf16, WS_CTL + 512 * 1024);
    const bf16* sf = cz == 128 ? zero : FW(bf16, WS_KV) + (size_t)128 * 262144 + (size_t)(h * 2) * 16384;
    const bf16* sb = cz == 129 ? zero : FW(bf16, WS_KV) + (size_t)129 * 262144 + (size_t)(h * 2 + 1) * 16384;
    ret_ld_pair(sf, 128, sb, 128, F.tid, R); ret_st_pair(Sf, Sb, F.tid, R); ret_ld_kv(F, it, R); ret_st_pair(Kn, Vt, F.tid, R);
    __syncthreads();
    ret_item(F0, l, it, -1, R);
    __syncthreads();
}
DI void ph_attn_scan(const Frame& F0, int l) { const Frame F = launder(F0);
    LAS float* scf = (LAS float*)(F.lds + SCR_OFF);
    if (F.wave == 0) { const float* qg = F.a->in[I_QG] + l * HD; const float* kg = F.a->in[I_KG] + l * HD;
        float a = fmaxf(fabsf(qg[F.lane]), fabsf(qg[F.lane + 64])), b = fmaxf(fabsf(kg[F.lane]), fabsf(kg[F.lane + 64]));
        float s = F.lane < 8 ? F.a->in[I_SINK][l * 8 + F.lane] : -3.0e38f;
#pragma unroll
        for (int o = 1; o < 64; o <<= 1) { a = fmaxf(a, __shfl_xor(a, o)); b = fmaxf(b, __shfl_xor(b, o)); s = fmaxf(s, __shfl_xor(s, o)); }
        if (F.lane == 0) scf[0] = fmaxf(11.313708499f * a * b * 1.03f, s) * 1.44269504089f; }
    __syncthreads();
    const float m2 = scf[0];
    const int NX = (l == 0 && F.G >= 64) ? 24 : 0;
    const bool scans = F.bx >= NX, scan_first = ((F.bx >> 3) & 1) == 0;
    if (scans && scan_first) scan_share(F0, l, F.bx - NX, F.G - NX);
    const int NA = 512 + (l == 0 ? 8 : 0);
    for (int it = F.bx; it < NA; it += F.G) { const int b = it < 512 ? (it >> 2) : 128 + ((it - 512) >> 2), kvh = (it >> 1) & 1, pair = it & 1; attn_item(F, l, b, kvh, pair, m2); }
    __syncthreads();
    if (NX) { if (F.bx >= 8 && F.bx < 24) ret_ctx_item(F0, l, 1024 + F.bx - 8); }
    if (scans && !scan_first) scan_share(F0, l, F.bx - NX, F.G - NX);
}
DI void ph_retout(const Frame& F0, int l) { const Frame F = launder(F0);
    const int NI = (l == 0 && F.G < 64 ? NBLK : 128) * 8;
    LAS unsigned char* Kn = F.lds; LAS unsigned char* Vt = F.lds + 34816; LAS unsigned char* Sf = F.lds + 2 * 34816; LAS unsigned char* Sb = F.lds + 3 * 34816;
    v4u R[8];
    int it = F.bx;
    if (it < NI) { ret_ld_state(F, it, R); ret_st_pair(Sf, Sb, F.tid, R); ret_ld_kv(F, it, R); ret_st_pair(Kn, Vt, F.tid, R); }
    __syncthreads();
    for (; it < NI; it += F.G) ret_item(F0, l, it, it + F.G < NI ? it + F.G : -1, R);
}

DI void ph_gather(const Frame& F0) { const Frame F = launder(F0);
    LAS int* sc = (LAS int*)(F.lds + SCR_OFF);
    const int* RBCNT = (const int*)(F.a->ws + WS_RBCNT); const v4u* SEL = (const v4u*)(F.a->ws + WS_SEL); int* TOKSLOT = (int*)(F.a->ws + WS_TOKSLOT); int* PTAB = (int*)(F.a->ws + WS_PTAB);
    int* SLOTTOK = (int*)(F.a->ws + WS_SLOTTOK); float* SLOTG = (float*)(F.a->ws + WS_SLOTG);
    const int ge = F.tid & 7, gk = F.tid >> 3; int rc[4];
#pragma unroll
    for (int m = 0; m < 4; ++m) rc[m] = RBCNT[(gk + 64 * m) * 8 + ge];
    { int t = (rc[0] + rc[1]) + (rc[2] + rc[3]); t += __shfl_xor(t, 8); t += __shfl_xor(t, 16); t += __shfl_xor(t, 32); if (F.lane < 8) sc[32 + F.wave * 8 + F.lane] = t; }
    __syncthreads();
    if (F.tid < 8) { int t = 0; for (int w = 0; w < NWAVES; ++w) t += sc[32 + w * 8 + F.tid]; sc[F.tid] = t; }
    __syncthreads();
    if (F.tid == 0) { int r0 = 0, p = 0; for (int e = 0; e < 8; ++e) { sc[8 + e] = r0; const int np = (sc[e] + 255) >> 8; if (F.bx == 0) for (int k = 0; k < np; ++k) PTAB[1 + p + k] = e; p += np; r0 += np * 256; } if (F.bx == 0) PTAB[0] = p; }
    __syncthreads();
    if (F.bx < 8) { const int e = F.bx, lo = sc[8 + e] + sc[e], hi = sc[8 + e] + (((sc[e] + 255) >> 8) << 8); for (int s = lo + F.tid; s < hi; s += NTHR) { SLOTTOK[s] = -1; SLOTG[s] = 0.f; } }
    for (int rb = F.bx; rb < 256; rb += F.G) {
        { int t = 0;
#pragma unroll
          for (int m = 0; m < 4; ++m) t += (gk + 64 * m) < rb ? rc[m] : 0;
          t += __shfl_xor(t, 8); t += __shfl_xor(t, 16); t += __shfl_xor(t, 32); if (F.lane < 8) sc[96 + F.wave * 8 + F.lane] = t; }
        __syncthreads();
        if (F.tid < 8) { int b = sc[8 + F.tid]; for (int w = 0; w < NWAVES; ++w) b += sc[96 + w * 8 + F.tid]; sc[16 + F.tid] = b; sc[24 + F.tid] = 0; }
        __syncthreads();
        if (F.tid < 128) { const int t = rb * 64 + (F.tid >> 1), p = F.tid & 1; const v4u sv = SEL[t];
            const int e = p ? (int)((sv.x >> 8) & 0xffu) : (int)(sv.x & 0xffu); const int pos = __hip_atomic_fetch_add(sc + 24 + e, 1, __ATOMIC_RELAXED, __HIP_MEMORY_SCOPE_WORKGROUP);
            const int slot = sc[16 + e] + pos; TOKSLOT[t * 2 + p] = slot; SLOTTOK[slot] = t; SLOTG[slot] = __uint_as_float(p ? sv.z : sv.y); }
        __syncthreads();
    }
}
DI void load_ptab(const Frame& F0) { const Frame F = launder(F0); LAS int* tab = (LAS int*)(F.lds + SCR_OFF); const int* PTAB = (const int*)(F.a->ws + WS_PTAB); for (int i = F.tid; i < 1 + PMAX; i += NTHR) tab[i] = PTAB[i];
    if (F.tid < 24) tab[176 + F.tid] = (int)((const unsigned*)(F.a->ws + WS_CTL))[CW_AMAX + F.tid];
    __syncthreads();
    if (F.tid == 0) { const int P = tab[0]; int e = 0; tab[160] = 0; for (int p = 0; p < P; ++p) { while (e < tab[1 + p]) { ++e; tab[160 + e] = p; } } while (e < 8) { ++e; tab[160 + e] = P; } }
    __syncthreads(); }

DI void ph_combine(const Frame& F0) { const Frame F = launder(F0);
    const v4u* SEL = (const v4u*)(F.a->ws + WS_SEL); const int* TOKSLOT = (const int*)(F.a->ws + WS_TOKSLOT);
    const float* gate = FW(float, WS_MODS) + 24576 + 5 * 2048;
    const int gw = F.bx * NWAVES + F.wave, NGW = F.G * NWAVES;
    const int P = ((const int*)(F.a->ws + WS_PTAB))[0]; const int full = ((8 * P) / F.G) * F.G;
    const int T = 8 * P - full, sp = pg8::tail_splits(T, F.G), tcap = sp ? F.G / sp : 0;
    const float* PT = FW(float, WS_PT);
    LAS int* tl = (LAS int*)F.lds;
    for (int i = F.tid; i < P * 8; i += NTHR) tl[i] = pg8::moe_index(i >> 3, i & 7, P, 8) - full;
    __syncthreads();
    f32x4 gt[8];
#pragma unroll
    for (int j = 0; j < 8; ++j) gt[j] = *(const f32x4*)(gate + 4 * F.lane + 256 * j);
    for (int t0 = gw; t0 < SEQ; t0 += 2 * NGW) {
        int tk[2], sl[2][2]; float gg[2][2]; v2u xv[2][8], ya[2][8], yb[2][8];
#pragma unroll
        for (int u = 0; u < 2; ++u) { tk[u] = t0 + u * NGW < SEQ ? t0 + u * NGW : t0; const v4u sv = SEL[tk[u]]; gg[u][0] = __uint_as_float(sv.y); gg[u][1] = __uint_as_float(sv.z);
            sl[u][0] = TOKSLOT[tk[u] * 2]; sl[u][1] = TOKSLOT[tk[u] * 2 + 1]; }
#pragma unroll
        for (int u = 0; u < 2; ++u) {
            const GAS v2u* xb = (const GAS v2u*)(FW(bf16, WS_XB) + (size_t)tk[u] * DM) + F.lane;
            const GAS v2u* y0 = (const GAS v2u*)(FW(bf16, WS_YP) + (size_t)sl[u][0] * DM) + F.lane; const GAS v2u* y1 = (const GAS v2u*)(FW(bf16, WS_YP) + (size_t)sl[u][1] * DM) + F.lane;
#pragma unroll
            for (int j = 0; j < 8; ++j) { xv[u][j] = xb[64 * j]; ya[u][j] = y0[64 * j]; yb[u][j] = y1[64 * j]; } }
#pragma unroll
        for (int u = 0; u < 2; ++u) {
            if (u == 1 && t0 + NGW >= SEQ) break;
            GAS f32x4* xo = (GAS f32x4*)(F.a->out + (size_t)tk[u] * DM) + F.lane;
            const LAS int* tp0 = tl + (sl[u][0] >> 8) * 8; const LAS int* tp1 = tl + (sl[u][1] >> 8) * 8;
#pragma unroll
            for (int j = 0; j < 8; ++j) {
                f32x4 a = (f32x4){bflo(ya[u][j].x), bfhi(ya[u][j].x), bflo(ya[u][j].y), bfhi(ya[u][j].y)}, b = (f32x4){bflo(yb[u][j].x), bfhi(yb[u][j].x), bflo(yb[u][j].y), bfhi(yb[u][j].y)};
                if (sp) {
                    const int i0 = tp0[j], i1 = tp1[j];
                    if (i0 >= 0) { a = (f32x4){0.f, 0.f, 0.f, 0.f};
#pragma unroll
                        for (int q = 0; q < 6; ++q) { const int qs = q < sp ? q : 0; const f32x4 v = *(const GAS f32x4*)(PT + ((size_t)(qs * tcap + i0) * 256 + (sl[u][0] & 255)) * 256 + 4 * F.lane); a += q < sp ? v : (f32x4){0.f, 0.f, 0.f, 0.f}; } }
                    if (i1 >= 0) { b = (f32x4){0.f, 0.f, 0.f, 0.f};
#pragma unroll
                        for (int q = 0; q < 6; ++q) { const int qs = q < sp ? q : 0; const f32x4 v = *(const GAS f32x4*)(PT + ((size_t)(qs * tcap + i1) * 256 + (sl[u][1] & 255)) * 256 + 4 * F.lane); b += q < sp ? v : (f32x4){0.f, 0.f, 0.f, 0.f}; } } }
                const f32x4 x = (f32x4){bflo(xv[u][j].x), bfhi(xv[u][j].x), bflo(xv[u][j].y), bfhi(xv[u][j].y)};
                xo[64 * j] = x + gt[j] * (gg[u][0] * a + gg[u][1] * b); } }
    }
}

#ifndef PG8_SP2
#define PG8_SP2 true
#endif
#ifndef PG8_ALIGN
#define PG8_ALIGN true
#endif
#ifndef MK_MULTI
#define MK_MULTI 0
#endif
constexpr int NPHASE = 26;
#ifndef PHASE_MASK
#define PHASE_MASK 0xffffffffu
#endif
#define PHM(j) ((PHASE_MASK >> (j)) & 1u)
#define IN(k) (lo <= (k) && (k) < hi)
#ifndef DUP_PHASE
#define DUP_PHASE (-1)
#define DUP_N 1
#endif
#define NREP(k) (((k) == DUP_PHASE) ? DUP_N : 1)
#define SEAM(k) do { if ((lo <= (k) && (k) + 1 < hi) || rep_ + 1 < NREP(k)) xcd_barrier(bar); } while (0)

#ifndef CVQ_IN
#define CVQ_IN 16
#define CVQ_FF 8
#endif
constexpr int CV_NIN = 106 * NWAVES * CVQ_IN, CV_NFF = 212 * NWAVES * CVQ_FF, CV0 = CVT_NMOE - 2 * CV_NIN - CV_NFF;
static_assert(CV0 > 0, "quota");
template <int l> DI void layer_body(const Frame& F0, const XcdBarrier& bar, const int lo, const int hi) {

        const int pb = 2 + 12 * l;
        const int MR = (l == 0) ? NROW : SEQ;
        if (PHM(2) && IN(pb + 0)) for (int rep_ = 0; rep_ < NREP(pb + 0); ++rep_) { ph_norm(F0, l, 0, NROW / 64, false); SEAM(pb + 0); }
        if (PHM(3) && IN(pb + 1)) for (int rep_ = 0; rep_ < NREP(pb + 1); ++rep_) {
            const Frame F = launder(F0); pg8::Gemm g{FW(bf16, WS_H), FW(bf16, WS_WIN) + (size_t)l * INC * DM, NROW, INC, DM, DM}; pg8::StaticOrder S; S.init(NROW, INC, F.G, F.bx);
            pg8::EpiStoreBf16 E{FW(bf16, WS_PROJ), INC, 1 << 30};
            pg8::gemm_phase<pg8::EpiStoreBf16, pg8::StaticOrder, PG8_ALIGN, PG8_SP2>(F.lds, g, S, E);
            if (F.G == 256 && F.bx >= 150) { const int lo = l == 0 ? CV0 : CV0 + CV_NIN + CV_NFF; cvt_moe_range(F0, lo, lo + CV_NIN, (F.bx - 150) * NWAVES + F.wave, 106 * NWAVES); }
            SEAM(pb + 1);
        }
        if (PHM(4) && IN(pb + 2)) for (int rep_ = 0; rep_ < NREP(pb + 2); ++rep_) { ph_prep_kv(F0, l); SEAM(pb + 2); }
        if (PHM(5) && IN(pb + 3)) for (int rep_ = 0; rep_ < NREP(pb + 3); ++rep_) { ph_attn_scan(F0, l); SEAM(pb + 3); }
        if (PHM(7) && IN(pb + 5)) for (int rep_ = 0; rep_ < NREP(pb + 5); ++rep_) { ph_retout(F0, l); SEAM(pb + 5); }
        if (PHM(8) && IN(pb + 6)) for (int rep_ = 0; rep_ < NREP(pb + 6); ++rep_) {
            const Frame F = launder(F0); pg8::Gemm g{FW(bf16, WS_MIX), FW(bf16, WS_WOUT) + (size_t)l * DM * DM, SEQ, DM, DM, DM}; pg8::StaticOrder S; S.init(SEQ, DM, F.G, F.bx);
            const float* md = FW(float, WS_MODS) + (size_t)l * 24576;
            pg8::EpiResidB<l == 0> E{F.a->in[I_X], FW(bf16, WS_XB), md + 2 * 2048, DM};
            pg8::gemm_phase<pg8::EpiResidB<l == 0>, pg8::StaticOrder, PG8_ALIGN, PG8_SP2>(F.lds, g, S, E);
            if constexpr (l == 0) {
                const Frame F = launder(F0);
                pg8::Gemm g2{FW(bf16, WS_MIX), FW(bf16, WS_WOUT), NROW, DM, 256, DM}; pg8::SplitOrder S2{64, 8, 8, 256, F.G, F.bx};
                pg8::EpiPartial E2{FW(float, WS_PC1), 256, DM};
                pg8::gemm_phase<pg8::EpiPartial, pg8::SplitOrder, PG8_ALIGN, PG8_SP2>(F.lds, g2, S2, E2);
            }
            SEAM(pb + 6);
        }
        if (PHM(2) && IN(pb + 7)) for (int rep_ = 0; rep_ < NREP(pb + 7); ++rep_) { ph_norm(F0, l, 1, MR / 64, l == 1); SEAM(pb + 7); }
        if constexpr (l == 0) {
            if (PHM(9) && IN(pb + 8)) for (int rep_ = 0; rep_ < NREP(pb + 8); ++rep_) {
                const Frame F = launder(F0); pg8::Gemm g{FW(bf16, WS_H), FW(bf16, WS_WF13), NROW, 2 * DFF, DM, DM}; pg8::StaticOrder S; S.init(NROW, 2 * DFF, F.G, F.bx);
                pg8::EpiSwiglu E{FW(bf16, WS_U), DFF, 1 << 30};
                pg8::gemm_phase<pg8::EpiSwiglu, pg8::StaticOrder, PG8_ALIGN, PG8_SP2>(F.lds, g, S, E);
                if (F.G == 256 && F.bx >= 44) cvt_moe_range(F0, CV0 + CV_NIN, CV0 + CV_NIN + CV_NFF, (F.bx - 44) * NWAVES + F.wave, 212 * NWAVES);
                SEAM(pb + 8);
            }
            if (PHM(10) && IN(pb + 9)) for (int rep_ = 0; rep_ < NREP(pb + 9); ++rep_) {
                const Frame F = launder(F0); pg8::Gemm g{FW(bf16, WS_U), FW(bf16, WS_WF2), SEQ, DM, DFF, DFF}; pg8::StaticOrder S; S.init(SEQ, DM, F.G, F.bx);
                const float* md = FW(float, WS_MODS);
                pg8::EpiResidB<false> E{nullptr, FW(bf16, WS_XB), md + 5 * 2048, DM};
                pg8::gemm_phase<pg8::EpiResidB<false>, pg8::StaticOrder, PG8_ALIGN, PG8_SP2>(F.lds, g, S, E);
                { const Frame F = launder(F0); pg8::Gemm g2{FW(bf16, WS_U), FW(bf16, WS_WF2), NROW, DM, 512, DFF}; pg8::SplitOrder S2{64, 8, 11, 512, F.G, F.bx};
                  pg8::EpiPartial E2{FW(float, WS_PC2), 512, DM};
                  pg8::gemm_phase<pg8::EpiPartial, pg8::SplitOrder, PG8_ALIGN, PG8_SP2>(F.lds, g2, S2, E2); }
                SEAM(pb + 9);
            }
        } else {
            if (PHM(11) && IN(pb + 8)) for (int rep_ = 0; rep_ < NREP(pb + 8); ++rep_) { ph_gather(F0); SEAM(pb + 8); }
            if (PHM(12) && IN(pb + 9)) for (int rep_ = 0; rep_ < NREP(pb + 9); ++rep_) {
                load_ptab(F0);
                const Frame F = launder(F0); pg8::Gemm g{FW(bf16, WS_H), FW(bf16, WS_WM13), PMAX * 256, 2 * DFF, DM / 2, DM / 2}; pg8::MoeOrderE S{(const LAS int*)(F.lds + SCR_OFF), 2 * DFF / 256, F.G, F.bx, (const int*)(F.a->ws + WS_SLOTTOK)};
                pg8::EpiSwiglu8 E{FW(unsigned char, WS_U), DFF, 2 * DFF / 256, (const LAS unsigned*)(F.lds + SCR_OFF) + 176, F8_SH, F8_SU};
                pg8::gemm_phase<pg8::EpiSwiglu8, pg8::MoeOrderE, PG8_ALIGN, PG8_SP2, true>(F.lds, g, S, E);
                SEAM(pb + 9);
            }
            if (PHM(13) && IN(pb + 10)) for (int rep_ = 0; rep_ < NREP(pb + 10); ++rep_) {
                load_ptab(F0);
                const Frame F = launder(F0); pg8::Gemm g{FW(bf16, WS_U), FW(bf16, WS_WM2), PMAX * 256, DM, DFF / 2, DFF / 2}; pg8::MoeOrder S{(const LAS int*)(F.lds + SCR_OFF), DM / 256, F.G, F.bx, 1};
                pg8::EpiStoreBf16S E{FW(bf16, WS_YP), DM, DM / 256, (const LAS unsigned*)(F.lds + SCR_OFF) + 176, F8_SU};
                pg8::gemm_phase<pg8::EpiStoreBf16S, pg8::MoeOrder, PG8_ALIGN, PG8_SP2, true>(F.lds, g, S, E);
                { const Frame F = launder(F0); pg8::MoeTailOrder S2{(const LAS int*)(F.lds + SCR_OFF), DM / 256, F.G, F.bx, DFF / 256}; const int sp = S2.splits();
                  if (sp) { pg8::Gemm g2{FW(bf16, WS_U), FW(bf16, WS_WM2), PMAX * 256, DM, DFF / 2, DFF / 2}; const int P = S2.tab[0];
                    pg8::EpiTailPartial E2{FW(float, WS_PT), P, DM / 256, ((8 * P) / F.G) * F.G, F.G / sp, (const LAS unsigned*)(F.lds + SCR_OFF) + 176, F8_SU};
                    pg8::gemm_phase<pg8::EpiTailPartial, pg8::MoeTailOrder, PG8_ALIGN, PG8_SP2, true>(F.lds, g2, S2, E2); } }
                SEAM(pb + 10);
            }
            if (PHM(14) && IN(pb + 11)) { ph_combine(F0); }
        }
    }
__global__ void __launch_bounds__(NTHR, 2) fwd_kernel(Args args) {
    extern __shared__ __attribute__((aligned(16))) unsigned char lds[];
    Frame F0;
    F0.lds = (LAS unsigned char*)lds;
    F0.tid = threadIdx.x; F0.lane = F0.tid & 63; F0.wave = __builtin_amdgcn_readfirstlane(F0.tid >> 6); F0.G = gridDim.x; F0.bx = blockIdx.x;
    F0.a = (const __attribute__((address_space(4))) Args*)__builtin_amdgcn_kernarg_segment_ptr();
    unsigned char* ws = args.ws;
    volatile LAS unsigned* MISC = (volatile LAS unsigned*)(F0.lds + MISC_OFF);
    for (int u = F0.tid; u < (LDS_BYTES - MISC_OFF) / 4; u += NTHR) ((LAS unsigned*)(F0.lds + MISC_OFF))[u] = 0u;
    __syncthreads();
    const int lo = args.ph_lo, hi = args.ph_hi;
    XcdBarrier bar; bar.bar = (unsigned*)(ws + WS_CTL) + CW_BAR; bar.x = 0; bar.st = MISC + 8;
    if (hi - lo > 1) bar = xcd_barrier_post((unsigned*)(ws + WS_CTL) + CW_BAR, MISC + 8);
    if (PHM(0) && IN(0)) for (int rep_ = 0; rep_ < NREP(0); ++rep_) { ph_ada(F0); SEAM(0); }
    if (PHM(1) && IN(1)) for (int rep_ = 0; rep_ < NREP(1); ++rep_) { ph_cvt(F0, F0.G == 256 ? CV0 : CVT_NMOE); SEAM(1); }
    layer_body<0>(F0, bar, lo, hi);
    layer_body<1>(F0, bar, lo, hi);
#undef IN
#undef SEAM
}

extern "C" void kernel_launch(void* const* d_in, const int* in_sizes, int n_in, void* d_out, int out_size, void* d_ws, size_t ws_size, hipStream_t stream) {
    static int grid = 0;
    if (grid == 0) {
        if (n_in != 23 || out_size != SEQ * DM || ws_size < WS_END) { fprintf(stderr, "kernel_launch: unexpected shapes (n_in %d, out %d, ws %zu); nothing launched\n", n_in, out_size, ws_size); grid = -1; return; }
        int dev = 0, cus = 0, per_cu = 0;
        if (hipGetDevice(&dev) != hipSuccess || hipDeviceGetAttribute(&cus, hipDeviceAttributeMultiprocessorCount, dev) != hipSuccess) { grid = -1; return; }
        if (hipFuncSetAttribute((const void*)fwd_kernel, hipFuncAttributeMaxDynamicSharedMemorySize, LDS_BYTES) != hipSuccess) { fprintf(stderr, "kernel_launch: hipFuncSetAttribute failed\n"); grid = -1; return; }
        if (hipOccupancyMaxActiveBlocksPerMultiprocessor(&per_cu, (const void*)fwd_kernel, NTHR, LDS_BYTES) != hipSuccess || per_cu < 1) { fprintf(stderr, "kernel_launch: occupancy query says %d blocks per CU\n", per_cu); }
        (void)hipGetLastError();
        grid = cus;
    }
    if (grid < 0) return;
    (void)hipMemsetAsync((char*)d_ws + WS_CTL, 0, CTL_ZERO_BYTES, stream);
    Args a{};
    for (int i = 0; i < 23; ++i) a.in[i] = (const float*)d_in[i];
    a.out = (float*)d_out; a.ws = (unsigned char*)d_ws;
#if MK_MULTI
    for (int p = 0; p < NPHASE; ++p) { if (p == 2 + 4 || p == 2 + 10 || p == 2 + 11 || p == 14 + 4) continue; a.ph_lo = p; a.ph_hi = p + 1; hipLaunchKernelGGL(fwd_kernel, dim3(grid), dim3(NTHR), LDS_BYTES, stream, a); }
#else
    a.ph_lo = 0; a.ph_hi = NPHASE;
    hipLaunchKernelGGL(fwd_kernel, dim3(grid), dim3(NTHR), LDS_BYTES, stream, a);
#endif
    (void)in_sizes;
}
```

```cpp
#include <hip/hip_runtime.h>
#include <cstdio>
#include <cstdint>
namespace pg8 {
#define PG8_LAS __attribute__((address_space(3)))
typedef unsigned short bf16_t;
typedef short bf16x8 __attribute__((ext_vector_type(8)));
typedef float f32x4 __attribute__((ext_vector_type(4)));
typedef unsigned u32x4 __attribute__((ext_vector_type(4)));
typedef int i32x4 __attribute__((ext_vector_type(4)));
typedef int i32x8 __attribute__((ext_vector_type(8)));
constexpr int BM = 256, BK = 64, HALF = 128, HTB = HALF * BK * 2  , STAGE_BYTES = 8 * HTB, NXCD = 8, WGM = 8;

__host__ __device__ __forceinline__ int lds_byte(int r, int c) { const int st = (r >> 4) * 2 + (c >> 5), rr = r & 15, cc = c & 31, ob = rr * 64 + cc * 2; return st * 1024 + (ob ^ (((ob >> 9) & 1) << 5)); }
__host__ __device__ __forceinline__ void stage_rc(int b, int& R, int& C) { const int st = b / 1024, sb = b % 1024, swz = sb ^ (((sb >> 9) & 1) << 5); R = (st >> 1) * 16 + swz / 64; C = (st & 1) * 32 + (swz % 64) / 2; }
__host__ __device__ __forceinline__ int perm32(int rho) { const int n = rho >> 4, i = rho & 15; return 8 * (i >> 2) + 4 * n + (i & 3); }

struct Unit { int pm, pn, ko, kt; };
struct Gemm { const bf16_t* A; const bf16_t* Bt; int M, N, K, ld; };

struct StaticOrder {
    static constexpr bool GATHER = false, VARK = false;
    int nM, nN, nwg, G, c;
    __host__ __device__ void init(int M, int N, int G_, int c_) { nM = M / BM; nN = N / BM; nwg = nM * nN; G = G_; c = c_; }
    int full_only = 0;
    __host__ __device__ bool next(int i, Unit& u) const {
        const long L = (long)i * G + c; if (L >= (full_only ? (nwg / G) * G : nwg)) return false; unit_of(L, u); return true; }
    __host__ __device__ void unit_of(long L, Unit& u) const {
        int wgid = (int)L; { const int q = nwg / NXCD, r = nwg % NXCD, xcd = wgid % NXCD, off = wgid / NXCD; wgid = (xcd < r ? xcd * (q + 1) : r * (q + 1) + (xcd - r) * q) + off; }
        const int nig = WGM * nN, gid = wgid / nig, fm = gid * WGM, gsz = (nM - fm) < WGM ? (nM - fm) : WGM;
        u.pm = fm + ((wgid % nig) % gsz); u.pn = (wgid % nig) / gsz; u.ko = 0;
    }
    __device__ __forceinline__ void a_ready(const Unit&) const {}
    __device__ __forceinline__ void done(const Unit&) const {}
};
struct SplitTailOrder {
    static constexpr bool GATHER = false, VARK = true;
    StaticOrder S0; int npair;
    __host__ __device__ int tail() const { return S0.nwg - (S0.nwg / S0.G) * S0.G; }
    __host__ __device__ bool next(int i, Unit& u) const {
        const int T = tail(); if (i > 0 || T == 0 || S0.c >= T * 4) return false;
        const int t = S0.c % T, ks = S0.c / T; S0.unit_of((long)(S0.nwg / S0.G) * S0.G + t, u);
        const int np = npair / 4; u.ko = ks * np * 2 * BK; u.kt = (2 * np) | (ks << 8) | (t << 16); return true;
    }
    __device__ __forceinline__ void a_ready(const Unit&) const {}
    __device__ __forceinline__ void done(const Unit&) const {}
};


__device__ __forceinline__ unsigned cvt_pk_bf16(float lo, float hi) { unsigned r; asm volatile("v_cvt_pk_bf16_f32 %0, %1, %2" : "=v"(r) : "v"(lo), "v"(hi)); return r; }
__device__ __forceinline__ float f8_scale(unsigned amax_bits) { const int ex = (int)((amax_bits >> 23) & 0xffu); if (ex == 0 || ex == 255) return 1.f;
    int se = 127 + 5 - (ex - 127); se = se < 1 ? 1 : (se > 254 ? 254 : se); return __uint_as_float((unsigned)se << 23); }
__device__ __forceinline__ unsigned pk4_fp8(float a, float b, float c, float d) {
    a = fminf(fmaxf(a, -448.f), 448.f); b = fminf(fmaxf(b, -448.f), 448.f); c = fminf(fmaxf(c, -448.f), 448.f); d = fminf(fmaxf(d, -448.f), 448.f);
    int w = __builtin_amdgcn_cvt_pk_fp8_f32(a, b, 0, false); w = __builtin_amdgcn_cvt_pk_fp8_f32(c, d, w, true); return (unsigned)w; }

__host__ __device__ __forceinline__ void moe_unit(long L, int P, int nN, int& pm, int& pn) {
    const int nwg = P * nN; int wgid = (int)L; { const int q = nwg / NXCD, r = nwg % NXCD, xcd = wgid % NXCD, off = wgid / NXCD; wgid = (xcd < r ? xcd * (q + 1) : r * (q + 1) + (xcd - r) * q) + off; }
    const int nig = WGM * nN, gid = wgid / nig, fm = gid * WGM, gsz = (P - fm) < WGM ? (P - fm) : WGM;
    pm = fm + ((wgid % nig) % gsz); pn = (wgid % nig) / gsz;
}
__host__ __device__ __forceinline__ int moe_index(int pm, int pn, int P, int nN) {
    const int nwg = P * nN, nig = WGM * nN, gid = pm / WGM, fm = gid * WGM, gsz = (P - fm) < WGM ? (P - fm) : WGM; const int wgid = gid * nig + pn * gsz + (pm - fm);
    const int q = nwg / NXCD, r = nwg % NXCD; int xcd, off; if (wgid < r * (q + 1)) { xcd = wgid / (q + 1); off = wgid % (q + 1); } else { const int t2 = wgid - r * (q + 1); xcd = r + t2 / q; off = t2 % q; }
    return off * NXCD + xcd;
}
struct MoeOrder {
    static constexpr bool GATHER = false, VARK = false;
    const PG8_LAS int* tab; int nN, G, c; int full_only;
    __device__ __forceinline__ bool next(int i, Unit& u) const {
        const int P = tab[0]; const long L = (long)i * G + c; const long U = (long)P * nN, lim = full_only ? (U / G) * G : U; if (L >= lim) return false;
        int pm, pn; moe_unit(L, P, nN, pm, pn); u.pm = pm; u.pn = tab[1 + pm] * nN + pn; u.ko = 0; return true;
    }
    __device__ __forceinline__ void a_ready(const Unit&) const {}
    __device__ __forceinline__ void done(const Unit&) const {}
};

struct MoeOrderE {
    static constexpr bool GATHER = true, VARK = false;
    const PG8_LAS int* tab; int nN, G, c; const int* slot_tok;
    __device__ __forceinline__ int arow(const Unit& u, int r) const { const int t = slot_tok[u.pm * BM + r]; return t < 0 ? 0 : t; }
    __device__ __forceinline__ bool next(int i, Unit& u) const {
        long L = (long)i * G + c; int e = 0, p0 = 0, np = 0;
        for (; e < 8; ++e) { p0 = tab[160 + e]; np = tab[161 + e] - p0; const long ue = (long)np * nN; if (L < ue) break; L -= ue; }
        if (e >= 8) return false;
        int pm, pn; moe_unit(L, np, nN, pm, pn); u.pm = p0 + pm; u.pn = e * nN + pn; u.ko = 0; return true;
    }
    __device__ __forceinline__ void a_ready(const Unit&) const {}
    __device__ __forceinline__ void done(const Unit&) const {}
};
__host__ __device__ __forceinline__ int tail_splits(int T, int G) { return T == 0 ? 0 : (G / T >= 6 ? 6 : (G / T >= 1 ? G / T : 1)); }
struct MoeTailOrder {
    static constexpr bool GATHER = false, VARK = true;
    const PG8_LAS int* tab; int nN, G, c, npair;
    __device__ __forceinline__ int splits() const { const int P = tab[0]; const long U = (long)P * nN; return tail_splits((int)(U - (U / G) * G), G); }
    __device__ __forceinline__ bool next(int i, Unit& u) const {
        const int P = tab[0]; const long U = (long)P * nN, full = (U / G) * G; const int T = (int)(U - full), s = tail_splits(T, G); const long j = (long)i * G + c; if (s == 0 || j >= (long)T * s) return false;
        const long L = full + j / s; const int ks = (int)(j % s); int pm, pn; moe_unit(L, P, nN, pm, pn); u.pm = pm; u.pn = tab[1 + pm] * nN + pn;
        const int base = npair / s, rem = npair % s, np = base + (ks < rem ? 1 : 0), p0 = ks * base + (ks < rem ? ks : rem);
        u.ko = p0 * 2 * BK; u.kt = (2 * np) | (ks << 8); return true;
    }
    __device__ __forceinline__ void a_ready(const Unit&) const {}
    __device__ __forceinline__ void done(const Unit&) const {}
};
struct SplitOrder {
    static constexpr bool GATHER = false, VARK = false;
    int pm0, nN, nS, ksplit, G, c;
    __device__ __forceinline__ bool next(int i, Unit& u) const { const long L = (long)i * G + c; if (L >= (long)nN * nS) return false; u.pm = pm0; u.pn = (int)(L % nN); u.ko = (int)(L / nN) * ksplit; return true; }
    __device__ __forceinline__ void a_ready(const Unit&) const {}
    __device__ __forceinline__ void done(const Unit&) const {}
};
struct EpiStoreBf16 {
    static constexpr bool PERM = true, AFTER_DRAIN = false;
    bf16_t* O; int ldc; int pn_mod;
    __device__ __forceinline__ void operator()(const f32x4 (&acc)[2][2][4][2], const Unit& u, int wr, int wc, int fr, int fq) const {
        const int row0 = u.pm * BM + wr * 64 + fr; const int col0 = (u.pn % pn_mod) * BM + wc * 32 + 8 * fq;
#pragma unroll
        for (int ai = 0; ai < 2; ++ai)
#pragma unroll
            for (int m = 0; m < 4; ++m) { bf16_t* rowp = O + (size_t)(row0 + ai * HALF + m * 16) * ldc + col0;
#pragma unroll
                for (int bj = 0; bj < 2; ++bj) { const f32x4 v0 = acc[ai][bj][m][0], v1 = acc[ai][bj][m][1];
                    u32x4 w; w.x = cvt_pk_bf16(v0[0], v0[1]); w.y = cvt_pk_bf16(v0[2], v0[3]); w.z = cvt_pk_bf16(v1[0], v1[1]); w.w = cvt_pk_bf16(v1[2], v1[3]);
                    *(u32x4*)(rowp + bj * HALF) = w; } }
    }
};
struct EpiSwiglu {
    static constexpr bool PERM = true, AFTER_DRAIN = false;
    bf16_t* O; int ldc; int pn_mod;
    __device__ __forceinline__ void operator()(const f32x4 (&acc)[2][2][4][2], const Unit& u, int wr, int wc, int fr, int fq) const {
        const int row0 = u.pm * BM + wr * 64 + fr; const int col0 = (u.pn % pn_mod) * HALF + wc * 32 + 8 * fq;
#pragma unroll
        for (int ai = 0; ai < 2; ++ai)
#pragma unroll
            for (int m = 0; m < 4; ++m) { bf16_t* rowp = O + (size_t)(row0 + ai * HALF + m * 16) * ldc + col0;
                float r[8];
#pragma unroll
                for (int n = 0; n < 2; ++n)
#pragma unroll
                    for (int i = 0; i < 4; ++i) { const float a = acc[ai][0][m][n][i], b = acc[ai][1][m][n][i];
                        const float sg = __builtin_amdgcn_rcpf(1.0f + __builtin_amdgcn_exp2f(-1.44269504089f * a)); r[n * 4 + i] = a * sg * b; }
                u32x4 w; w.x = cvt_pk_bf16(r[0], r[1]); w.y = cvt_pk_bf16(r[2], r[3]); w.z = cvt_pk_bf16(r[4], r[5]); w.w = cvt_pk_bf16(r[6], r[7]);
                *(u32x4*)rowp = w; }
    }
};
struct EpiSwigluQuad {
    static constexpr bool PERM = true, AFTER_DRAIN = false, WADJ = false;
    bf16_t* O; int ldc; int pn_mod; float* PT; unsigned* flag;
    typedef unsigned long long u64;
    __device__ __forceinline__ void operator()(const f32x4 (&acc)[2][2][4][2], const Unit& u, int wr, int wc, int fr, int fq) const {
        const int ksr = (u.kt >> 8) & 255;
        if (ksr == 0) quad<0>(acc, u, wr, wc, fr, fq); else if (ksr == 1) quad<1>(acc, u, wr, wc, fr, fq); else if (ksr == 2) quad<2>(acc, u, wr, wc, fr, fq); else quad<3>(acc, u, wr, wc, fr, fq);
    }
    template <int ks> __device__ __forceinline__ void quad(const f32x4 (&acc)[2][2][4][2], const Unit& u, int wr, int wc, int fr, int fq) const {
        const int t = u.kt >> 16; const int tid = (wr * 4 + wc) * 64 + fq * 16 + fr;
#pragma unroll
        for (int dq = 0; dq < 4; ++dq) { if (dq == ks) continue; constexpr int dummy_ = 0; (void)dummy_; const int ai = dq >> 1, m0 = 2 * (dq & 1);
            u64* P = (u64*)PT + ((size_t)((t * 4 + dq) * 4 + ks) * 16) * 512 + tid;
#pragma unroll
            for (int bj = 0; bj < 2; ++bj)
#pragma unroll
                for (int mm = 0; mm < 2; ++mm)
#pragma unroll
                    for (int n = 0; n < 2; ++n) { const f32x4 v = acc[ai][bj][m0 + mm][n]; const int e2 = ((bj * 2 + mm) * 2 + n) * 2;
                        __hip_atomic_store(P + (size_t)e2 * 512, (u64)__float_as_uint(v[0]) | ((u64)__float_as_uint(v[1]) << 32), __ATOMIC_RELAXED, __HIP_MEMORY_SCOPE_AGENT);
                        __hip_atomic_store(P + (size_t)(e2 + 1) * 512, (u64)__float_as_uint(v[2]) | ((u64)__float_as_uint(v[3]) << 32), __ATOMIC_RELAXED, __HIP_MEMORY_SCOPE_AGENT); } }
        asm volatile("s_waitcnt vmcnt(0)" ::: "memory");
        if (fr == 0 && fq == 0) {
#pragma unroll
            for (int dq = 0; dq < 4; ++dq) if (dq != ks) __hip_atomic_fetch_add(flag + t * 4 + dq, 1u, __ATOMIC_RELAXED, __HIP_MEMORY_SCOPE_AGENT); }
        { unsigned spins = 0; while (__hip_atomic_load(flag + t * 4 + ks, __ATOMIC_RELAXED, __HIP_MEMORY_SCOPE_AGENT) < 24u && ++spins < (1u << 22)) __builtin_amdgcn_s_sleep(2); }
        asm volatile("s_waitcnt vmcnt(0)" ::: "memory");
        const int ai = ks >> 1, m0 = 2 * (ks & 1);
        u64 pr[3][16];
#pragma unroll
        for (int s3 = 0; s3 < 3; ++s3) { const int src = s3 + (s3 >= ks ? 1 : 0); const u64* P = (const u64*)PT + ((size_t)((t * 4 + ks) * 4 + src) * 16) * 512 + tid;
#pragma unroll
            for (int e2 = 0; e2 < 16; ++e2) pr[s3][e2] = __hip_atomic_load(P + (size_t)e2 * 512, __ATOMIC_RELAXED, __HIP_MEMORY_SCOPE_AGENT); }
        const int row0 = u.pm * BM + wr * 64 + fr; const int col0 = (u.pn % pn_mod) * HALF + wc * 32 + 8 * fq;
#pragma unroll
        for (int mm = 0; mm < 2; ++mm) { bf16_t* rowp = O + (size_t)(row0 + ai * HALF + (m0 + mm) * 16) * ldc + col0;
            f32x4 v[2][2];
#pragma unroll
            for (int bj = 0; bj < 2; ++bj)
#pragma unroll
                for (int n = 0; n < 2; ++n) { v[bj][n] = acc[ai][bj][m0 + mm][n]; const int e2 = ((bj * 2 + mm) * 2 + n) * 2;
#pragma unroll
                    for (int s3 = 0; s3 < 3; ++s3) { const u64 a = pr[s3][e2], b = pr[s3][e2 + 1];
                        v[bj][n] += (f32x4){__uint_as_float((unsigned)a), __uint_as_float((unsigned)(a >> 32)), __uint_as_float((unsigned)b), __uint_as_float((unsigned)(b >> 32))}; } }
            float r[8];
#pragma unroll
            for (int n = 0; n < 2; ++n)
#pragma unroll
                for (int i = 0; i < 4; ++i) { const float a = v[0][n][i], b = v[1][n][i];
                    const float sg = __builtin_amdgcn_rcpf(1.0f + __builtin_amdgcn_exp2f(-1.44269504089f * a)); r[n * 4 + i] = a * sg * b; }
            u32x4 w; w.x = cvt_pk_bf16(r[0], r[1]); w.y = cvt_pk_bf16(r[2], r[3]); w.z = cvt_pk_bf16(r[4], r[5]); w.w = cvt_pk_bf16(r[6], r[7]);
            *(u32x4*)rowp = w; }
    }
};
struct EpiSwiglu8 {
    static constexpr bool PERM = true, AFTER_DRAIN = false;
    unsigned char* O; int ldc; int pn_mod; const PG8_LAS unsigned* amax; float sa, so;
    __device__ __forceinline__ void operator()(const f32x4 (&acc)[2][2][4][2], const Unit& u, int wr, int wc, int fr, int fq) const {
        const int row0 = u.pm * BM + wr * 64 + fr; const int col0 = (u.pn % pn_mod) * HALF + wc * 32 + 8 * fq; const int ex = u.pn / pn_mod;
        const float i1 = 1.f / (sa * f8_scale(amax[3 * ex])), i3 = so / (sa * f8_scale(amax[3 * ex + 1]));
#pragma unroll
        for (int ai = 0; ai < 2; ++ai)
#pragma unroll
            for (int m = 0; m < 4; ++m) { unsigned char* rowp = O + (size_t)(row0 + ai * HALF + m * 16) * ldc + col0;
                float r[8];
#pragma unroll
                for (int n = 0; n < 2; ++n)
#pragma unroll
                    for (int i = 0; i < 4; ++i) { const float a = acc[ai][0][m][n][i] * i1, b = acc[ai][1][m][n][i] * i3;
                        const float sg = __builtin_amdgcn_rcpf(1.0f + __builtin_amdgcn_exp2f(-1.44269504089f * a)); r[n * 4 + i] = a * sg * b; }
                uint2 w; w.x = pk4_fp8(r[0], r[1], r[2], r[3]); w.y = pk4_fp8(r[4], r[5], r[6], r[7]);
                *(uint2*)rowp = w; }
    }
};
struct EpiStoreBf16S {
    static constexpr bool PERM = true, AFTER_DRAIN = false;
    bf16_t* O; int ldc; int pn_mod; const PG8_LAS unsigned* amax; float sa;
    __device__ __forceinline__ void operator()(const f32x4 (&acc)[2][2][4][2], const Unit& u, int wr, int wc, int fr, int fq) const {
        const int row0 = u.pm * BM + wr * 64 + fr; const int col0 = (u.pn % pn_mod) * BM + wc * 32 + 8 * fq; const float inv = 1.f / (sa * f8_scale(amax[3 * (u.pn / pn_mod) + 2]));
#pragma unroll
        for (int ai = 0; ai < 2; ++ai)
#pragma unroll
            for (int m = 0; m < 4; ++m) { bf16_t* rowp = O + (size_t)(row0 + ai * HALF + m * 16) * ldc + col0;
#pragma unroll
                for (int bj = 0; bj < 2; ++bj) { const f32x4 v0 = acc[ai][bj][m][0] * inv, v1 = acc[ai][bj][m][1] * inv;
                    u32x4 w; w.x = cvt_pk_bf16(v0[0], v0[1]); w.y = cvt_pk_bf16(v0[2], v0[3]); w.z = cvt_pk_bf16(v1[0], v1[1]); w.w = cvt_pk_bf16(v1[2], v1[3]);
                    *(u32x4*)(rowp + bj * HALF) = w; } }
    }
};
struct EpiResid {
    static constexpr bool PERM = false, AFTER_DRAIN = false;
    const float* res0; float* out0; const float* gate0; int ldc;
    __device__ __forceinline__ void operator()(const f32x4 (&acc)[2][2][4][2], const Unit& u, int wr, int wc, int fr, int fq) const {
        const int row0 = u.pm * BM + wr * 64 + fr, col0 = u.pn * BM + wc * 32 + 4 * fq;
        f32x4 gv[2][2];
#pragma unroll
        for (int bj = 0; bj < 2; ++bj)
#pragma unroll
            for (int n = 0; n < 2; ++n) gv[bj][n] = *(const f32x4*)(gate0 + col0 + bj * HALF + n * 16);
#pragma unroll
        for (int ai = 0; ai < 2; ++ai) {
            f32x4 r[4][2][2];
#pragma unroll
            for (int m = 0; m < 4; ++m) { const size_t off = (size_t)(row0 + ai * HALF + m * 16) * ldc + col0;
#pragma unroll
                for (int bj = 0; bj < 2; ++bj)
#pragma unroll
                    for (int n = 0; n < 2; ++n) r[m][bj][n] = *(const f32x4*)(res0 + off + bj * HALF + n * 16); }
#pragma unroll
            for (int m = 0; m < 4; ++m) { const size_t off = (size_t)(row0 + ai * HALF + m * 16) * ldc + col0;
#pragma unroll
                for (int bj = 0; bj < 2; ++bj)
#pragma unroll
                    for (int n = 0; n < 2; ++n) *(f32x4*)(out0 + off + bj * HALF + n * 16) = r[m][bj][n] + gv[bj][n] * acc[ai][bj][m][n]; }
        }
    }
};

struct EpiPartial {
    static constexpr bool PERM = false, AFTER_DRAIN = false;
    float* P; int ksplit; int ldc;
    __device__ __forceinline__ void operator()(const f32x4 (&acc)[2][2][4][2], const Unit& u, int wr, int wc, int fr, int fq) const {
        const int row0 = wr * 64 + fr, col0 = u.pn * BM + wc * 32 + 4 * fq; float* base = P + (size_t)(u.ko / ksplit) * BM * ldc;
#pragma unroll
        for (int ai = 0; ai < 2; ++ai)
#pragma unroll
            for (int m = 0; m < 4; ++m) { float* rp = base + (size_t)(row0 + ai * HALF + m * 16) * ldc + col0;
#pragma unroll
                for (int bj = 0; bj < 2; ++bj)
#pragma unroll
                    for (int n = 0; n < 2; ++n) *(f32x4*)(rp + bj * HALF + n * 16) = acc[ai][bj][m][n]; }
    }
};
template <bool RES32> struct EpiResidB {
    static constexpr bool PERM = true, AFTER_DRAIN = false;
    const float* res32; bf16_t* xb; const float* gate; int ldc;
    __device__ __forceinline__ void operator()(const f32x4 (&acc)[2][2][4][2], const Unit& u, int wr, int wc, int fr, int fq) const {
        const int row0 = u.pm * BM + wr * 64 + fr; const int col0 = u.pn * BM + wc * 32 + 8 * fq;
        f32x4 gv[2][2];
#pragma unroll
        for (int bj = 0; bj < 2; ++bj)
#pragma unroll
            for (int n = 0; n < 2; ++n) gv[bj][n] = *(const f32x4*)(gate + col0 + bj * HALF + 4 * n);
#pragma unroll
        for (int ai = 0; ai < 2; ++ai) {
            f32x4 r[4][2][2];
#pragma unroll
            for (int m = 0; m < 4; ++m) { const size_t off = (size_t)(row0 + ai * HALF + m * 16) * ldc + col0;
#pragma unroll
                for (int bj = 0; bj < 2; ++bj) {
                    if constexpr (RES32) { r[m][bj][0] = *(const f32x4*)(res32 + off + bj * HALF); r[m][bj][1] = *(const f32x4*)(res32 + off + bj * HALF + 4); }
                    else { const u32x4 w = *(const u32x4*)(xb + off + bj * HALF);
                        r[m][bj][0] = (f32x4){__uint_as_float(w.x << 16), __uint_as_float(w.x & 0xffff0000u), __uint_as_float(w.y << 16), __uint_as_float(w.y & 0xffff0000u)};
                        r[m][bj][1] = (f32x4){__uint_as_float(w.z << 16), __uint_as_float(w.z & 0xffff0000u), __uint_as_float(w.w << 16), __uint_as_float(w.w & 0xffff0000u)}; } } }
#pragma unroll
            for (int m = 0; m < 4; ++m) { const size_t off = (size_t)(row0 + ai * HALF + m * 16) * ldc + col0;
#pragma unroll
                for (int bj = 0; bj < 2; ++bj) { const f32x4 v0 = r[m][bj][0] + gv[bj][0] * acc[ai][bj][m][0], v1 = r[m][bj][1] + gv[bj][1] * acc[ai][bj][m][1];
                    u32x4 w; w.x = cvt_pk_bf16(v0[0], v0[1]); w.y = cvt_pk_bf16(v0[2], v0[3]); w.z = cvt_pk_bf16(v1[0], v1[1]); w.w = cvt_pk_bf16(v1[2], v1[3]);
                    *(u32x4*)(xb + off + bj * HALF) = w; } }
        }
    }
};
struct EpiTailPartial {
    static constexpr bool PERM = false, AFTER_DRAIN = false;
    float* PT; int P, nN, full, tcap; const PG8_LAS unsigned* amax; float sa;
    __device__ __forceinline__ void operator()(const f32x4 (&acc)[2][2][4][2], const Unit& u, int wr, int wc, int fr, int fq) const {
        const int idx = moe_index(u.pm, u.pn % nN, P, nN) - full, s = u.kt >> 8; const float inv = 1.f / (sa * f8_scale(amax[3 * (u.pn / nN) + 2]));
        float* base = PT + (size_t)(s * tcap + idx) * (BM * BM) + (size_t)(wr * 64 + fr) * BM + wc * 32 + 4 * fq;
#pragma unroll
        for (int ai = 0; ai < 2; ++ai)
#pragma unroll
            for (int m = 0; m < 4; ++m) { float* rp = base + (size_t)(ai * HALF + m * 16) * BM;
#pragma unroll
                for (int bj = 0; bj < 2; ++bj)
#pragma unroll
                    for (int n = 0; n < 2; ++n) *(f32x4*)(rp + bj * HALF + n * 16) = acc[ai][bj][m][n] * inv; }
    }
};
template <class Epi, class Sched, bool ALIGN_EPI = false, bool SP2 = false, bool FP8 = false>
__device__ __forceinline__ void gemm_phase(PG8_LAS unsigned char* lds, const Gemm g, const Sched& S, const Epi& E) {
    int tid_ = threadIdx.x; asm volatile("" : "+v"(tid_)); const int tid = tid_, wid = __builtin_amdgcn_readfirstlane(tid >> 6), lane = tid & 63, wr = wid >> 2, wc = wid & 3, fr = lane & 15, fq = lane >> 4;
    const int K = g.ld; int nt = g.K / BK;
    unsigned voffA[2], voffB[2];
#pragma unroll
    for (int i = 0; i < 2; ++i) { int R, C; stage_rc(tid * 16 + i * 8192, R, C); const int Rb = Epi::PERM ? ((R & ~31) + perm32(R & 31)) : R;
        voffA[i] = (unsigned)(R * K + C) * 2u; voffB[i] = (unsigned)(Rb * K + C) * 2u; }
    const size_t kstep = (size_t)(BK * 2);
    const size_t hstep = (size_t)HALF * K * 2;
    const size_t tstep = 2 * hstep;
    const unsigned ldsw = (unsigned)wid * 1024u;
    const int aoff = lds_byte(wr * 64 + fr, fq * 8), boff = lds_byte(wc * 32 + fr, fq * 8);
#define PG8_SA(b, h) (((b) * 2 + (h)) * HTB)
#define PG8_SB(b, h) ((4 + (b) * 2 + (h)) * HTB)
#define PG8_STAGE(bufoff, gbase, voff) do { _Pragma("unroll") for (int _i = 0; _i < 2; ++_i) \
        __builtin_amdgcn_global_load_lds((const unsigned*)((const char*)(gbase) + (voff)[_i]), (PG8_LAS unsigned*)(lds + (bufoff) + ldsw + _i * 8192), 16, 0, 0); } while (0)
#define PG8_LD8(p) __builtin_shufflevector(*(const PG8_LAS i32x4*)(p), *(const PG8_LAS i32x4*)((p) + 1024), 0, 1, 2, 3, 4, 5, 6, 7)
#define PG8_LDA(dst, b, h) do { if constexpr (FP8) { _Pragma("unroll") for (int m = 0; m < 4; ++m) dst##8[m] = PG8_LD8(lds + PG8_SA(b, h) + aoff + m * 2048); } else { \
        _Pragma("unroll") for (int m = 0; m < 4; ++m) _Pragma("unroll") for (int k = 0; k < 2; ++k) dst[m][k] = *(const PG8_LAS bf16x8*)(lds + PG8_SA(b, h) + aoff + m * 2048 + k * 1024); } } while (0)
#define PG8_LDB(dst, b, h) do { if constexpr (FP8) { _Pragma("unroll") for (int n = 0; n < 2; ++n) dst##8[n] = PG8_LD8(lds + PG8_SB(b, h) + boff + n * 2048); } else { \
        _Pragma("unroll") for (int n = 0; n < 2; ++n) _Pragma("unroll") for (int k = 0; k < 2; ++k) dst[n][k] = *(const PG8_LAS bf16x8*)(lds + PG8_SB(b, h) + boff + n * 2048 + k * 1024); } } while (0)
#define PG8_CAT8(x, y) __builtin_shufflevector(__builtin_bit_cast(i32x4, x), __builtin_bit_cast(i32x4, y), 0, 1, 2, 3, 4, 5, 6, 7)
#define PG8_MMA(ai, bj, At, Bt) do { __builtin_amdgcn_s_setprio(1); if constexpr (FP8) { _Pragma("unroll") for (int m = 0; m < 4; ++m) _Pragma("unroll") for (int n = 0; n < 2; ++n) \
        asm volatile("v_mfma_f32_16x16x128_f8f6f4 %0, %1, %2, %0" : "+v"(acc[ai][bj][m][n]) : "v"(Bt##8[n]), "v"(At##8[m])); } else { \
        _Pragma("unroll") for (int m = 0; m < 4; ++m) _Pragma("unroll") for (int n = 0; n < 2; ++n) _Pragma("unroll") for (int k = 0; k < 2; ++k) \
        acc[ai][bj][m][n] = __builtin_amdgcn_mfma_f32_16x16x32_bf16(Bt[n][k], At[m][k], acc[ai][bj][m][n], 0, 0, 0); } __builtin_amdgcn_s_setprio(0); } while (0)
#define PG8_WAIT_V(n) asm volatile("s_waitcnt vmcnt(" #n ")" ::: "memory")
#define PG8_WAIT_L(n) asm volatile("s_waitcnt lgkmcnt(" #n ")" ::: "memory")
#define PG8_BAR __builtin_amdgcn_s_barrier()
#define PG8_SCHED __builtin_amdgcn_sched_barrier(0)
    Unit cur, nxt; int ui = 0;
    if (!S.next(0, cur)) return;
    if constexpr (Sched::VARK) nt = cur.kt & 255;
    unsigned va[2][2], vn[2][2]; int gR[2], gC[2];
    if constexpr (Sched::GATHER) {
#pragma unroll
        for (int i = 0; i < 2; ++i) { stage_rc(tid * 16 + i * 8192, gR[i], gC[i]); }
#pragma unroll
        for (int h = 0; h < 2; ++h)
#pragma unroll
            for (int i = 0; i < 2; ++i) { va[h][i] = (unsigned)(S.arow(cur, 128 * h + gR[i]) * K + gC[i]) * 2u; vn[h][i] = va[h][i]; }
    }
#define PG8_STAGEA(bufoff, gbase, h, nx) do { if constexpr (Sched::GATHER) { _Pragma("unroll") for (int _i = 0; _i < 2; ++_i) { const unsigned _vo = (nx) ? vn[h][_i] : va[h][_i]; \
        __builtin_amdgcn_global_load_lds((const unsigned*)((const char*)(gbase) + _vo), (PG8_LAS unsigned*)(lds + (bufoff) + ldsw + _i * 8192), 16, 0, 0); } } \
        else { PG8_STAGE(bufoff, (gbase) + ((h) ? hstep : 0), voffA); } } while (0)
    f32x4 acc[2][2][4][2];
#pragma unroll
    for (int a = 0; a < 2; ++a)
#pragma unroll
        for (int b = 0; b < 2; ++b)
#pragma unroll
            for (int m = 0; m < 4; ++m)
#pragma unroll
                for (int n = 0; n < 2; ++n) acc[a][b][m][n] = (f32x4){0.f, 0.f, 0.f, 0.f};
    bf16x8 At[4][2], B0[2][2], B1[2][2]; i32x8 At8[4], B08[2], B18[2];
    const char* cA = (const char*)g.A + (Sched::GATHER ? (size_t)0 : (size_t)cur.pm * tstep) + (size_t)cur.ko * 2; const char* cB = (const char*)g.Bt + (size_t)cur.pn * tstep + (size_t)cur.ko * 2;
    S.a_ready(cur);
    if constexpr (SP2) {
        PG8_STAGE(PG8_SB(0, 0), cB, voffB); PG8_STAGE(PG8_SB(0, 1), cB + hstep, voffB); PG8_STAGEA(PG8_SA(0, 0), cA, 0, false); PG8_STAGEA(PG8_SA(0, 1), cA, 1, false);
        if (wr == 1) PG8_BAR;
        PG8_WAIT_V(2); PG8_BAR;
        PG8_STAGE(PG8_SB(1, 0), cB + kstep, voffB); PG8_STAGEA(PG8_SA(1, 0), cA + kstep, 0, false); PG8_STAGE(PG8_SB(1, 1), cB + hstep + kstep, voffB);
        PG8_WAIT_V(6); PG8_BAR;
    } else {
        PG8_STAGE(PG8_SB(0, 0), cB, voffB); PG8_STAGEA(PG8_SA(0, 0), cA, 0, false); PG8_STAGE(PG8_SB(0, 1), cB + hstep, voffB); PG8_STAGEA(PG8_SA(0, 1), cA, 1, false);
        if (wr == 1) PG8_BAR;
        PG8_WAIT_V(4); PG8_BAR;
        PG8_STAGE(PG8_SB(1, 0), cB + kstep, voffB); PG8_STAGEA(PG8_SA(1, 0), cA + kstep, 0, false); PG8_STAGE(PG8_SB(1, 1), cB + hstep + kstep, voffB);
        PG8_WAIT_V(6); PG8_BAR;
    }
    for (;;) {
        const bool has_next = S.next(ui + 1, nxt);
        if constexpr (Sched::GATHER) { if (has_next) {
#pragma unroll
            for (int h = 0; h < 2; ++h)
#pragma unroll
                for (int i = 0; i < 2; ++i) vn[h][i] = (unsigned)(S.arow(nxt, 128 * h + gR[i]) * K + gC[i]) * 2u; }
            else {
#pragma unroll
                for (int h = 0; h < 2; ++h)
#pragma unroll
                    for (int i = 0; i < 2; ++i) vn[h][i] = va[h][i]; } }
        const char* nA = has_next ? (const char*)g.A + (Sched::GATHER ? (size_t)0 : (size_t)nxt.pm * tstep) + (size_t)nxt.ko * 2 : cA; const char* nB = has_next ? (const char*)g.Bt + (size_t)nxt.pn * tstep + (size_t)nxt.ko * 2 : cB;
        for (int t = 0; t < nt; t += 2) {
            const bool last = (t == nt - 2);
            const char* a1 = cA + (size_t)(t + 1) * kstep;
            const char* a2 = last ? nA : cA + (size_t)(t + 2) * kstep; const char* b2 = last ? nB : cB + (size_t)(t + 2) * kstep;
            const char* a3 = a2 + kstep; const char* b3 = b2 + kstep;
            if (last && has_next) S.a_ready(nxt);
            if constexpr (SP2) {
            PG8_LDB(B0, 0, 0); PG8_LDB(B1, 0, 1); PG8_SCHED; PG8_LDA(At, 0, 0); PG8_STAGEA(PG8_SA(1, 1), a1, 1, false);
            PG8_WAIT_V(8); PG8_WAIT_L(0); PG8_BAR; PG8_MMA(0, 0, At, B0); PG8_MMA(0, 1, At, B1); PG8_BAR; PG8_SCHED;
            PG8_LDA(At, 0, 1); PG8_STAGE(PG8_SB(0, 0), b2, voffB); PG8_STAGE(PG8_SB(0, 1), b2 + hstep, voffB); PG8_STAGEA(PG8_SA(0, 0), a2, 0, last);
            PG8_WAIT_V(8); PG8_WAIT_L(0); PG8_BAR; PG8_MMA(1, 0, At, B0); PG8_MMA(1, 1, At, B1); PG8_BAR; PG8_SCHED;
            PG8_LDB(B0, 1, 0); PG8_LDB(B1, 1, 1); PG8_SCHED; PG8_LDA(At, 1, 0); PG8_STAGEA(PG8_SA(0, 1), a2, 1, last);
            PG8_WAIT_V(8); PG8_WAIT_L(0); PG8_BAR; PG8_MMA(0, 0, At, B0); PG8_MMA(0, 1, At, B1); PG8_BAR; PG8_SCHED;
            PG8_LDA(At, 1, 1); PG8_STAGE(PG8_SB(1, 0), b3, voffB); PG8_STAGE(PG8_SB(1, 1), b3 + hstep, voffB); PG8_STAGEA(PG8_SA(1, 0), a3, 0, last);
            PG8_WAIT_V(8); PG8_WAIT_L(0); PG8_BAR; PG8_MMA(1, 0, At, B0); PG8_MMA(1, 1, At, B1); PG8_BAR; PG8_SCHED;
            } else {
            PG8_LDB(B0, 0, 0); PG8_SCHED; PG8_LDA(At, 0, 0); PG8_STAGEA(PG8_SA(1, 1), a1, 1, false);
            PG8_WAIT_L(8); PG8_BAR; PG8_WAIT_L(0); PG8_MMA(0, 0, At, B0); PG8_BAR; PG8_SCHED;
            PG8_LDB(B1, 0, 1); PG8_STAGE(PG8_SB(0, 0), b2, voffB);
            PG8_BAR; PG8_WAIT_L(0); PG8_MMA(0, 1, At, B1); PG8_BAR;
            PG8_LDA(At, 0, 1); PG8_STAGEA(PG8_SA(0, 0), a2, 0, last);
            PG8_BAR; PG8_WAIT_L(0); PG8_MMA(1, 0, At, B0); PG8_BAR; PG8_SCHED;
            PG8_STAGE(PG8_SB(0, 1), b2 + hstep, voffB);
            PG8_WAIT_V(6); PG8_BAR; PG8_MMA(1, 1, At, B1); PG8_BAR;
            PG8_LDB(B0, 1, 0); PG8_SCHED; PG8_LDA(At, 1, 0); PG8_STAGEA(PG8_SA(0, 1), a2, 1, last);
            PG8_WAIT_L(8); PG8_BAR; PG8_WAIT_L(0); PG8_MMA(0, 0, At, B0); PG8_BAR; PG8_SCHED;
            PG8_LDB(B1, 1, 1); PG8_STAGE(PG8_SB(1, 0), b3, voffB);
            PG8_BAR; PG8_WAIT_L(0); PG8_MMA(0, 1, At, B1); PG8_BAR;
            PG8_LDA(At, 1, 1); PG8_STAGEA(PG8_SA(1, 0), a3, 0, last);
            PG8_BAR; PG8_WAIT_L(0); PG8_MMA(1, 0, At, B0); PG8_BAR; PG8_SCHED;
            PG8_STAGE(PG8_SB(1, 1), b3 + hstep, voffB);
            PG8_WAIT_V(6); PG8_BAR; PG8_MMA(1, 1, At, B1); PG8_BAR;
            }
        }
        if constexpr (ALIGN_EPI) { if (wr == 0) PG8_BAR; }
        if constexpr (FP8) asm volatile("s_nop 15\n\ts_nop 15\n\ts_nop 15" ::: "memory");
        if constexpr (!Epi::AFTER_DRAIN) { E(acc, cur, wr, wc, fr, fq); S.done(cur); }
        if (!has_next) break;
#pragma unroll
        for (int a = 0; a < 2; ++a)
#pragma unroll
            for (int b = 0; b < 2; ++b)
#pragma unroll
                for (int m = 0; m < 4; ++m)
#pragma unroll
                    for (int n = 0; n < 2; ++n) acc[a][b][m][n] = (f32x4){0.f, 0.f, 0.f, 0.f};
        cur = nxt; cA = nA; cB = nB; ++ui;
        if constexpr (Sched::VARK) nt = cur.kt & 255;
        if constexpr (Sched::GATHER) {
#pragma unroll
            for (int h = 0; h < 2; ++h)
#pragma unroll
                for (int i = 0; i < 2; ++i) va[h][i] = vn[h][i]; }
        if constexpr (ALIGN_EPI) { if (wr == 1) PG8_BAR; }
    }
    PG8_WAIT_V(0);
    if constexpr (!ALIGN_EPI) { if (wr == 0) PG8_BAR; }
    PG8_BAR;
    if constexpr (Epi::AFTER_DRAIN) { E.fused(acc, cur, wr, wc, fr, fq, lds, wid, lane); S.done(cur); }
#undef PG8_SA
#undef PG8_SB
#undef PG8_STAGE
#undef PG8_STAGEA
#undef PG8_LDA
#undef PG8_LD8
#undef PG8_LDB
#undef PG8_MMA
#undef PG8_CAT8
#undef PG8_WAIT_V
#undef PG8_WAIT_L
#undef PG8_BAR
#undef PG8_SCHED
}
}

constexpr int DM = 2048, SEQ = 16384, CTXN = 256, NROW = SEQ + CTXN, HD = 128, INC = 5632, DFF = 5632, NEXP = 8;
constexpr int C_QA = 0, C_KA = 1024, C_VA = 1280, C_QR = 1536, C_KR = 2560, C_VR = 3584, C_GR = 4608;
constexpr int NBLK = NROW / 128;
constexpr int PMAX = 136;
constexpr float EPS = 1e-6f;
constexpr int NWAVES = 8, NTHR = 512;

constexpr size_t MiB = 1u << 20;
constexpr size_t WS_CTL = 0, CTL_ZERO_BYTES = 1 * MiB;
constexpr size_t WS_MODS = 1 * MiB;
constexpr size_t WS_PART = 2 * MiB;
constexpr size_t WS_ROPE = 5 * MiB;
constexpr size_t WS_SEL = 6 * MiB;
constexpr size_t WS_SLOTTOK = 6 * MiB + 512 * 1024;
constexpr size_t WS_SLOTG = 6 * MiB + 768 * 1024;
constexpr size_t WS_TOKSLOT = 7 * MiB;
constexpr size_t WS_RBCNT = 8 * MiB;
constexpr size_t WS_PTAB = 8 * MiB + 65536;
constexpr size_t WS_XCTX = 10 * MiB;
constexpr size_t WS_WIN = 16 * MiB;
constexpr size_t WS_WOUT = 60 * MiB;
constexpr size_t WS_WF13 = 76 * MiB;
constexpr size_t WS_WF2 = 120 * MiB;
constexpr size_t WS_WM13 = 142 * MiB;
constexpr size_t WS_WM2 = 494 * MiB;
constexpr size_t WS_H = 670 * MiB;
constexpr size_t WS_RA = 735 * MiB;
constexpr size_t WS_PROJ = WS_RA, WS_KV = WS_RA + 179 * MiB, WS_SPREV = WS_RA + 309 * MiB, WS_U = WS_RA;
constexpr size_t WS_RB = 1109 * MiB;
constexpr size_t WS_MIX = WS_RB, WS_VAT = WS_RB + 65 * MiB, WS_VRT = WS_RB + 107 * MiB, WS_H2G = WS_RB;
constexpr size_t WS_YP = 1249 * MiB;
constexpr size_t WS_PC1 = 1385 * MiB;
constexpr size_t WS_PC2 = 1401 * MiB;
constexpr size_t WS_XB = 1423 * MiB;
constexpr size_t WS_PT = 1487 * MiB;
constexpr size_t WS_END = 1551 * MiB;
static_assert((size_t)NROW * INC * 2 <= 179 * MiB && (size_t)NBLK * 8 * 2 * 128 * 128 * 4 <= 130 * MiB && (size_t)NBLK * 8 * 2 * 128 * 128 * 2 <= 65 * MiB && (size_t)PMAX * 256 * DFF * 2 <= 374 * MiB, "region A");
static_assert((size_t)NROW * DM * 2 <= 65 * MiB && (size_t)NBLK * 2 * 128 * 128 * 2 <= 9 * MiB && (size_t)NBLK * 8 * 128 * 128 * 2 <= 33 * MiB && (size_t)PMAX * 256 * DM * 2 <= 140 * MiB, "region B");
constexpr int CW_TFLAG = 20480;
constexpr int CW_AMAX = 16384;
constexpr float F8_SH = 2.f, F8_SU = 2.f;
constexpr int CW_BAR = 4096;

constexpr int SCR_OFF = 143360;
constexpr int MISC_OFF = 147456;
constexpr int LDS_BYTES = 151552;

#define GAS __attribute__((address_space(1)))
#define LAS __attribute__((address_space(3)))
#define DI __device__ __forceinline__
typedef unsigned short bf16;
typedef unsigned v4u __attribute__((ext_vector_type(4)));
typedef unsigned v2u __attribute__((ext_vector_type(2)));
typedef float f32x4 __attribute__((ext_vector_type(4)));
typedef float f32x2 __attribute__((ext_vector_type(2)));
typedef short bf16x8 __attribute__((ext_vector_type(8)));
#define LDS_WAIT() asm volatile("s_waitcnt lgkmcnt(0)" ::: "memory")
#define VM_WAIT() asm volatile("s_waitcnt vmcnt(0)" ::: "memory")
#define MFMA16(a, b, c) __builtin_amdgcn_mfma_f32_16x16x32_bf16((a), (b), (c), 0, 0, 0)
DI unsigned pk2(float lo, float hi) { return pg8::cvt_pk_bf16(lo, hi); }
DI unsigned pk2_safe(float lo, float hi) { const unsigned a = __float_as_uint(lo), b = __float_as_uint(hi); return ((a + 0x7fffu + ((a >> 16) & 1u)) >> 16) | ((b + 0x7fffu + ((b >> 16) & 1u)) & 0xffff0000u); }
DI float bflo(unsigned w) { return __uint_as_float(w << 16); }
DI float bfhi(unsigned w) { return __uint_as_float(w & 0xffff0000u); }
DI float ex2(float x) { return __builtin_amdgcn_exp2f(x); }
DI float wave_sum(float v) {
#pragma unroll
    for (int o = 1; o < 64; o <<= 1) v += __shfl_xor(v, o);
    return v;
}

#define XB_TMO      128
#define XB_XCNT(j)  (256  + 64 * (j))
#define XB_XSUB(j)  (1280 + 64 * (j))
#define XB_XGEN(j)  (2304 + 64 * (j))
#define XB_TOP      3328
#define XB_TOPGEN   3392
#define XCD_BAR_WORDS 3456
#define XB_SPIN_CAP (1u << 18)

__device__ __forceinline__ unsigned xb_ld(unsigned* p)              { return __hip_atomic_load(p, __ATOMIC_RELAXED, __HIP_MEMORY_SCOPE_AGENT); }
__device__ __forceinline__ unsigned xb_add(unsigned* p, unsigned v) { return __hip_atomic_fetch_add(p, v, __ATOMIC_RELAXED, __HIP_MEMORY_SCOPE_AGENT); }
__device__ __forceinline__ unsigned xb_xcc_id() { return (unsigned)__builtin_amdgcn_s_getreg((3 << 11) | 20) & 0xFu; }
#define XB_SPIN(cond, bar) do { unsigned _sp = 0; while (cond) { __builtin_amdgcn_s_sleep(1); \
    if ((++_sp & 255u) == 0u) { if (xb_ld(&(bar)[XB_TMO])) break; if (_sp > XB_SPIN_CAP) { atomicAdd(&(bar)[XB_TMO], 1u); break; } } } } while (0)

struct XcdBarrier {
    unsigned* bar; unsigned x;
    volatile LAS unsigned* st;
};

__device__ __forceinline__ XcdBarrier xcd_barrier_post(unsigned* bar, volatile LAS unsigned* st) {
    XcdBarrier b; b.bar = bar; b.x = xb_xcc_id(); b.st = st;
    if (threadIdx.x == 0) (void)xb_add(&bar[XB_XCNT(b.x)], 1u);
    return b;
}
__device__ __forceinline__ void xcd_barrier_complete(unsigned* bar, unsigned x, unsigned& nloc, unsigned& nx) {
    const unsigned G = gridDim.x * gridDim.y * gridDim.z;
    unsigned sum, cnt, mine, sp = 0u;
    for (;;) {
        sum = 0u; cnt = 0u; mine = 0u;
#pragma unroll
        for (unsigned j = 0; j < 16; ++j) { const unsigned c = xb_ld(&bar[XB_XCNT(j)]); sum += c; cnt += (c > 0u) ? 1u : 0u; mine = (j == x) ? c : mine; }
        if (sum == G) break;
        __builtin_amdgcn_s_sleep(1);
        if ((++sp & 255u) == 0u) { if (xb_ld(&bar[XB_TMO])) break; if (sp > XB_SPIN_CAP) { atomicAdd(&bar[XB_TMO], 1u); break; } }
    }
    nloc = mine > 0u ? mine : 1u; nx = cnt > 0u ? cnt : 1u;
}

__device__ __forceinline__ void xcd_barrier(const XcdBarrier& b) {
    asm volatile("s_waitcnt vmcnt(0)" ::: "memory");
    __syncthreads();
    if (threadIdx.x == 0) {
        unsigned* bar = b.bar;
        __builtin_amdgcn_s_waitcnt(0);
        unsigned nloc = b.st[0], nx = b.st[1];
        if (nloc == 0u) { xcd_barrier_complete(bar, b.x, nloc, nx); b.st[0] = nloc; b.st[1] = nx; }
        const unsigned old = xb_add(&bar[XB_XSUB(b.x)], 1u);
        const unsigned gen = old / nloc;
        if (old + 1u == (gen + 1u) * nloc) {
            __builtin_amdgcn_fence(__ATOMIC_RELEASE, "agent");
            asm volatile("s_waitcnt vmcnt(0)" ::: "memory");
            const unsigned og = xb_add(&bar[XB_TOP], 1u);
            const unsigned tg = og / nx;
            if (og + 1u == (tg + 1u) * nx) xb_add(&bar[XB_TOPGEN], 1u);
            else XB_SPIN(xb_ld(&bar[XB_TOPGEN]) == tg, bar);
            __builtin_amdgcn_fence(__ATOMIC_ACQUIRE, "agent");
            xb_add(&bar[XB_XGEN(b.x)], 1u);
            asm volatile("s_waitcnt vmcnt(0)" ::: "memory");
        } else {
            XB_SPIN(xb_ld(&bar[XB_XGEN(b.x)]) == gen, bar);
            __builtin_amdgcn_fence(__ATOMIC_ACQUIRE, "agent");
            asm volatile("s_waitcnt vmcnt(0)" ::: "memory");
        }
    }
    __syncthreads();
}

struct Args { const float* in[23]; float* out; unsigned char* ws; int ph_lo, ph_hi; };
struct Frame {
    LAS unsigned char* lds;
    int tid, lane, wave, G, bx;
    const __attribute__((address_space(4))) Args* a;
};
#define FW(T, off) ((T*)(F.a->ws + (off)))
DI Frame launder(const Frame& F0) { Frame F = F0; asm volatile("" : "+v"(F.tid)); const __attribute__((address_space(4))) Args* a = F0.a; asm volatile("" : "+s"(a)); F.a = a; F.lane = F.tid & 63; F.wave = __builtin_amdgcn_readfirstlane(F.tid >> 6); return F; }

enum { I_X = 0, I_C, I_CTX, I_CCTX, I_ADAW, I_ADAB, I_N1G, I_N2G, I_WIN, I_QG, I_KG, I_SINK, I_DECAY, I_GNG, I_WOUT, I_F1, I_F3, I_F2, I_RW, I_RB, I_M1, I_M3, I_M2 };

DI void ph_ada(const Frame& F0) { const Frame F = launder(F0);
    LAS float* sc = (LAS float*)F.lds;
    for (int i = F.tid; i < 2048; i += NTHR) { const float a = F.a->in[I_C][i], b = F.a->in[I_CCTX][i]; sc[i] = a / (1.f + expf(-a)); sc[2048 + i] = b / (1.f + expf(-b)); }
    __syncthreads();
    const int gw = F.bx * NWAVES + F.wave, NGW = F.G * NWAVES;
    for (int it = gw; it < 1536; it += NGW) {
        const int l = it / 768, r = it % 768, ks = r / 48, cg = r % 48;
        const GAS float* W = (const GAS float*)F.a->in[I_ADAW] + (size_t)l * 2048 * 12288 + (size_t)(ks * 128) * 12288 + cg * 256 + F.lane * 4;
        f32x4 a0 = (f32x4){0.f, 0.f, 0.f, 0.f}, a1 = a0;
#pragma unroll 8
        for (int k = 0; k < 128; ++k) { const f32x4 w = __builtin_nontemporal_load((const GAS f32x4*)(W + (size_t)k * 12288)); const float s0 = sc[ks * 128 + k], s1 = sc[2048 + ks * 128 + k]; a0 += s0 * w; a1 += s1 * w; }
        float* P = FW(float, WS_PART) + ((size_t)(l * 16 + ks) * 2) * 12288 + cg * 256 + F.lane * 4;
        *(f32x4*)P = a0; *(f32x4*)(P + 12288) = a1;
    }
    unsigned* AMAX = (unsigned*)(F.a->ws + WS_CTL) + CW_AMAX;
    for (int it = NGW - 1 - gw; it < 8 * 608; it += NGW) { const int e = it / 608, r = it % 608; const int k = r < 128 ? 0 : (r < 256 ? 1 : 2), row = (r - (k == 0 ? 0 : (k == 1 ? 128 : 256))) * 16, N = k == 2 ? DM : DFF;
        const float* W = (k == 0 ? F.a->in[I_M1] : (k == 1 ? F.a->in[I_M3] : F.a->in[I_M2])) + (size_t)e * DM * DFF;
        const GAS f32x4* p = (const GAS f32x4*)(W + (size_t)row * N) + F.lane; float m = 0.f;
        if (k == 2) { f32x4 v[8];
#pragma unroll
            for (int j = 0; j < 8; ++j) v[j] = p[64 * j];
#pragma unroll
            for (int j = 0; j < 8; ++j) m = fmaxf(m, fmaxf(fmaxf(fabsf(v[j].x), fabsf(v[j].y)), fmaxf(fabsf(v[j].z), fabsf(v[j].w)))); }
        else { f32x4 v[22];
#pragma unroll
            for (int j = 0; j < 22; ++j) v[j] = p[64 * j];
#pragma unroll
            for (int j = 0; j < 22; ++j) m = fmaxf(m, fmaxf(fmaxf(fabsf(v[j].x), fabsf(v[j].y)), fmaxf(fabsf(v[j].z), fabsf(v[j].w)))); }
#pragma unroll
        for (int o = 1; o < 64; o <<= 1) m = fmaxf(m, __shfl_xor(m, o));
        if (F.lane == 0) __hip_atomic_fetch_max(AMAX + 3 * e + k, __float_as_uint(m), __ATOMIC_RELAXED, __HIP_MEMORY_SCOPE_AGENT); }
    for (int i = F.bx * NTHR + F.tid; i < 8192; i += F.G * NTHR) { const int pos = i >> 5, p = i & 31; const float inv = exp2f(-(float)p * (13.287712379549449f / 32.f)); const float ang = (float)pos * inv;
        FW(float, WS_ROPE)[i] = cosf(ang); (FW(float, WS_ROPE) + 8192)[i] = sinf(ang); }
    __syncthreads();
}

DI void cvt_item(const float* W, int K, int N, bf16* WT, int mode, LAS float* scr, int item, int lane) {
    const int nblk = N / 32, kb = item / nblk, nb = item % nblk, k0 = 128 * kb, n0 = 32 * nb;
    const int r0 = mode ? ((n0 >> 7) * 256 + (n0 & 127) + (mode == 2 ? 128 : 0)) : n0;
    const GAS float* Wg = (const GAS float*)W;
    float tv[64];
#pragma unroll
    for (int i = 0; i < 64; ++i) tv[i] = __builtin_nontemporal_load(Wg + (size_t)(k0 + 2 * i + (lane >> 5)) * N + n0 + (lane & 31));
#pragma unroll
    for (int i = 0; i < 64; ++i) scr[(2 * i + (lane >> 5)) * 33 + (lane & 31)] = tv[i];
    LDS_WAIT(); asm volatile("" ::: "memory");
    const int c = lane & 15;
#pragma unroll
    for (int j = 0; j < 8; ++j) { const int n = (lane >> 4) + 4 * j; const LAS float* s = scr + (8 * c) * 33 + n;
        v4u o; o.x = pk2(s[0 * 33], s[1 * 33]); o.y = pk2(s[2 * 33], s[3 * 33]); o.z = pk2(s[4 * 33], s[5 * 33]); o.w = pk2(s[6 * 33], s[7 * 33]);
        *(GAS v4u*)(WT + (size_t)(r0 + n) * K + k0 + 8 * c) = o; }
    LDS_WAIT(); asm volatile("" ::: "memory");
}
DI void cvt8_item(const float* W, int K, int N, unsigned char* WT, int mode, LAS float* scr, int item, int lane, float sc) {
    const int nblk = N / 32, kb = item / nblk, nb = item % nblk, k0 = 128 * kb, n0 = 32 * nb;
    const int r0 = mode ? ((n0 >> 7) * 256 + (n0 & 127) + (mode == 2 ? 128 : 0)) : n0;
    const GAS float* Wg = (const GAS float*)W;
    float tv[64];
#pragma unroll
    for (int i = 0; i < 64; ++i) tv[i] = __builtin_nontemporal_load(Wg + (size_t)(k0 + 2 * i + (lane >> 5)) * N + n0 + (lane & 31));
#pragma unroll
    for (int i = 0; i < 64; ++i) scr[(2 * i + (lane >> 5)) * 33 + (lane & 31)] = tv[i] * sc;
    LDS_WAIT(); asm volatile("" ::: "memory");
    const int c = lane & 7;
#pragma unroll
    for (int j = 0; j < 4; ++j) { const int n = (lane >> 3) + 8 * j; const LAS float* s = scr + (16 * c) * 33 + n;
        v4u o; o.x = pg8::pk4_fp8(s[0 * 33], s[1 * 33], s[2 * 33], s[3 * 33]); o.y = pg8::pk4_fp8(s[4 * 33], s[5 * 33], s[6 * 33], s[7 * 33]);
        o.z = pg8::pk4_fp8(s[8 * 33], s[9 * 33], s[10 * 33], s[11 * 33]); o.w = pg8::pk4_fp8(s[12 * 33], s[13 * 33], s[14 * 33], s[15 * 33]);
        *(GAS v4u*)(WT + (size_t)(r0 + n) * K + k0 + 16 * c) = o; }
    LDS_WAIT(); asm volatile("" ::: "memory");
}
constexpr int CVT_IW = 2816, CVT_IO = 1024, CVT8_IW = 2816, CVT_NMOE = 24 * CVT8_IW;
DI void cvt_moe_item(const Frame& F, int r, LAS float* scr) {
    const int mi = r / CVT8_IW, e = mi / 3, k = mi % 3; r -= mi * CVT8_IW;
    const float sc = pg8::f8_scale(((const unsigned*)(F.a->ws + WS_CTL))[CW_AMAX + mi]);
    if (k == 0) cvt8_item(F.a->in[I_M1] + (size_t)e * DM * DFF, DM, DFF, FW(unsigned char, WS_WM13) + (size_t)e * 2 * DFF * DM, 1, scr, r, F.lane, sc);
    else if (k == 1) cvt8_item(F.a->in[I_M3] + (size_t)e * DM * DFF, DM, DFF, FW(unsigned char, WS_WM13) + (size_t)e * 2 * DFF * DM, 2, scr, r, F.lane, sc);
    else cvt8_item(F.a->in[I_M2] + (size_t)e * DFF * DM, DFF, DM, FW(unsigned char, WS_WM2) + (size_t)e * DM * DFF, 0, scr, r, F.lane, sc);
}
DI void ph_cvt(const Frame& F0, int moe_hi) { const Frame F = launder(F0);
    for (int i = F.bx * NTHR + F.tid; i < 49152; i += F.G * NTHR) { const int l = i / 24576, r = i % 24576, s = r / 12288, j = r % 12288; float sum = F.a->in[I_ADAB][l * 12288 + j];
        for (int ks = 0; ks < 16; ++ks) sum += FW(float, WS_PART)[((size_t)(l * 16 + ks) * 2 + s) * 12288 + j];
        FW(float, WS_MODS)[i] = sum; }
    LAS float* scr = (LAS float*)(F.lds + F.wave * 17408);
    const int gw = F.bx * NWAVES + F.wave, NGW = F.G * NWAVES;
    constexpr int IW = CVT_IW, IO = CVT_IO; const int NIT = 2 * (IW + IO) + 3 * IW + moe_hi;
    for (int it = gw; it < NIT; it += NGW) {
        int r = NIT - 1 - it;
        if (r < IW) { cvt_item(F.a->in[I_WIN], DM, INC, FW(bf16, WS_WIN), 0, scr, r, F.lane); continue; } r -= IW;
        if (r < IO) { cvt_item(F.a->in[I_WOUT], DM, DM, FW(bf16, WS_WOUT), 0, scr, r, F.lane); continue; } r -= IO;
        if (r < IW) { cvt_item(F.a->in[I_F1], DM, DFF, FW(bf16, WS_WF13), 1, scr, r, F.lane); continue; } r -= IW;
        if (r < IW) { cvt_item(F.a->in[I_F3], DM, DFF, FW(bf16, WS_WF13), 2, scr, r, F.lane); continue; } r -= IW;
        if (r < IW) { cvt_item(F.a->in[I_F2], DFF, DM, FW(bf16, WS_WF2), 0, scr, r, F.lane); continue; } r -= IW;
        if (r < IW) { cvt_item(F.a->in[I_WIN] + (size_t)DM * INC, DM, INC, FW(bf16, WS_WIN) + (size_t)INC * DM, 0, scr, r, F.lane); continue; } r -= IW;
        if (r < IO) { cvt_item(F.a->in[I_WOUT] + (size_t)DM * DM, DM, DM, FW(bf16, WS_WOUT) + (size_t)DM * DM, 0, scr, r, F.lane); continue; } r -= IO;
        if (r < moe_hi) cvt_moe_item(F, r, scr);
    }
    __syncthreads();
}
DI void cvt_moe_range(const Frame& F0, int lo, int hi, int wv, int nw) { const Frame F = launder(F0);
    LAS float* scr = (LAS float*)(F.lds + F.wave * 17408);
    for (int r = lo + wv; r < hi; r += nw) cvt_moe_item(F, r, scr);
    __syncthreads();
}

DI void ph_norm(const Frame& F0, int l, int which, int nrb, bool route) { const Frame F = launder(F0);
    LAS float* vA = (LAS float*)F.lds;
    LAS float* rwT = (LAS float*)(F.lds + 32768);
    LAS int* hist = (LAS int*)(F.lds + SCR_OFF);
    const float* g = F.a->in[which ? I_N2G : I_N1G] + l * DM;
    const float* md = FW(float, WS_MODS) + (size_t)l * 24576;
    for (int i = F.tid; i < 4096; i += NTHR) { const int s = i >> 11, d = i & 2047; const float sh = md[s * 12288 + (which * 3) * 2048 + d], scl = md[s * 12288 + (which * 3 + 1) * 2048 + d];
        vA[i] = g[d] * (1.f + scl); vA[4096 + i] = sh; }
    if (route) for (int i = F.tid; i < 4096; i += NTHR) { const int d = i >> 1, hh = i & 1; const f32x4 v = *(const f32x4*)(F.a->in[I_RW] + d * 8 + hh * 4);
        rwT[(hh * 4 + 0) * 2048 + d] = v.x; rwT[(hh * 4 + 1) * 2048 + d] = v.y; rwT[(hh * 4 + 2) * 2048 + d] = v.z; rwT[(hh * 4 + 3) * 2048 + d] = v.w; }
    __syncthreads();
    const bool first = (l == 0 && which == 0);
    const float* xc = (l == 0) ? F.a->in[I_CTX] : FW(float, WS_XCTX);
    v4u* SEL = (v4u*)(F.a->ws + WS_SEL); int* RBCNT = (int*)(F.a->ws + WS_RBCNT);
    const bool spread = (F.G == 256 && nrb == NROW / 64);
    for (int rb = F.bx; rb < (spread ? SEQ / 64 : nrb); rb += F.G) {
        if (route) { if (F.tid < 8) hist[F.tid] = 0; __syncthreads(); }
        for (int i = 0; i < (spread ? 9 : 8); ++i) {
            if (i == 8 && F.wave != 0) break;
            const int r = i == 8 ? SEQ + F.bx : rb * 64 + F.wave * 8 + i; const int s = r >= SEQ ? 1 : 0;
            f32x4 v[8]; float ss = 0.f;
            if (s || first) { const GAS f32x4* xr = (const GAS f32x4*)(s ? xc + (size_t)(r - SEQ) * DM : F.a->in[I_X] + (size_t)r * DM) + F.lane;
#pragma unroll
                for (int j = 0; j < 8; ++j) v[j] = xr[64 * j]; }
            else { const GAS v2u* xr = (const GAS v2u*)(FW(bf16, WS_XB) + (size_t)r * DM) + F.lane;
#pragma unroll
                for (int j = 0; j < 8; ++j) { const v2u w = xr[64 * j]; v[j] = (f32x4){bflo(w.x), bfhi(w.x), bflo(w.y), bfhi(w.y)}; } }
            if (s && l == 0 && which == 1) {
                const float* gt = md + 12288 + 2 * 2048; GAS f32x4* xw = (GAS f32x4*)(FW(float, WS_XCTX) + (size_t)(r - SEQ) * DM) + F.lane;
#pragma unroll
                for (int j = 0; j < 8; ++j) { f32x4 a = (f32x4){0.f, 0.f, 0.f, 0.f};
                    for (int sl = 0; sl < 8; ++sl) a += *((const GAS f32x4*)(FW(float, WS_PC1) + ((size_t)sl * 256 + (r - SEQ)) * DM) + F.lane + 64 * j);
                    v[j] = v[j] + *(const f32x4*)(gt + 4 * F.lane + 256 * j) * a; xw[64 * j] = v[j]; } }
            if (s && l == 1 && which == 0) {
                const float* gt = FW(float, WS_MODS) + 12288 + 5 * 2048;
#pragma unroll
                for (int j = 0; j < 8; ++j) { f32x4 a = (f32x4){0.f, 0.f, 0.f, 0.f};
                    for (int sl = 0; sl < 11; ++sl) a += *((const GAS f32x4*)(FW(float, WS_PC2) + ((size_t)sl * 256 + (r - SEQ)) * DM) + F.lane + 64 * j);
                    v[j] = v[j] + *(const f32x4*)(gt + 4 * F.lane + 256 * j) * a; } }
#pragma unroll
            for (int j = 0; j < 8; ++j) ss += (v[j].x * v[j].x + v[j].y * v[j].y) + (v[j].z * v[j].z + v[j].w * v[j].w);
            const float rstd = 1.f / sqrtf(wave_sum(ss) * (1.f / DM) + EPS);
            GAS v2u* o = (GAS v2u*)(FW(bf16, WS_H) + (size_t)r * DM) + F.lane; GAS unsigned* o8 = (GAS unsigned*)(FW(unsigned char, WS_H) + (size_t)r * DM) + F.lane;
#pragma unroll
            for (int j = 0; j < 8; ++j) { const f32x4 a = *(const LAS f32x4*)(vA + s * 2048 + 4 * F.lane + 256 * j), b = *(const LAS f32x4*)(vA + 4096 + s * 2048 + 4 * F.lane + 256 * j);
                v[j] = v[j] * rstd * a + b;
                if (route) o8[64 * j] = pg8::pk4_fp8(v[j].x * F8_SH, v[j].y * F8_SH, v[j].z * F8_SH, v[j].w * F8_SH);
                else { v2u w; w.x = pk2(v[j].x, v[j].y); w.y = pk2(v[j].z, v[j].w); o[64 * j] = w; } }
            if (route) {
                float lg[8];
#pragma unroll
                for (int e = 0; e < 8; ++e) { float t = 0.f;
#pragma unroll
                    for (int j = 0; j < 8; ++j) { const f32x4 w = *(const LAS f32x4*)(rwT + e * 2048 + 4 * F.lane + 256 * j); t += (v[j].x * w.x + v[j].y * w.y) + (v[j].z * w.z + v[j].w * w.w); }
                    lg[e] = wave_sum(t) + F.a->in[I_RB][e]; }
                int e0 = 0; float v0 = lg[0];
#pragma unroll
                for (int e = 1; e < 8; ++e) if (lg[e] > v0) { v0 = lg[e]; e0 = e; }
                int e1 = -1; float v1 = -3.0e38f;
#pragma unroll
                for (int e = 0; e < 8; ++e) if (e != e0 && lg[e] > v1) { v1 = lg[e]; e1 = e; }
                if (e1 < 0) { e1 = (e0 + 1) & 7; v1 = v0; }
                const float g0 = 1.f / (1.f + expf(v1 - v0)), g1 = 1.f - g0;
                if (F.lane == 0) { v4u sv; sv.x = (unsigned)e0 | ((unsigned)e1 << 8); sv.y = __float_as_uint(g0); sv.z = __float_as_uint(g1); sv.w = 0u; SEL[r] = sv;
                    __hip_atomic_fetch_add(hist + e0, 1, __ATOMIC_RELAXED, __HIP_MEMORY_SCOPE_WORKGROUP); __hip_atomic_fetch_add(hist + e1, 1, __ATOMIC_RELAXED, __HIP_MEMORY_SCOPE_WORKGROUP); }
            }
        }
        if (route) { __syncthreads(); if (F.tid < 8) RBCNT[rb * 8 + F.tid] = hist[F.tid]; __syncthreads(); }
    }
    __syncthreads();
}


DI void unpk8(const v4u w, float (&v)[8]) { v[0] = bflo(w.x); v[1] = bfhi(w.x); v[2] = bflo(w.y); v[3] = bfhi(w.y); v[4] = bflo(w.z); v[5] = bfhi(w.z); v[6] = bflo(w.w); v[7] = bfhi(w.w); }
DI v4u pk8(const float (&v)[8]) { v4u w; w.x = pk2(v[0], v[1]); w.y = pk2(v[2], v[3]); w.z = pk2(v[4], v[5]); w.w = pk2(v[6], v[7]); return w; }
DI void rope8(float (&x1)[8], float (&x2)[8], const float* tab) {
    const f32x4 c0 = *(const GAS f32x4*)tab, c1 = *(const GAS f32x4*)(tab + 4), s0 = *(const GAS f32x4*)(tab + 8192), s1 = *(const GAS f32x4*)(tab + 8196);
    const float cs[8] = {c0.x, c0.y, c0.z, c0.w, c1.x, c1.y, c1.z, c1.w}, sn[8] = {s0.x, s0.y, s0.z, s0.w, s1.x, s1.y, s1.z, s1.w};
#pragma unroll
    for (int i = 0; i < 8; ++i) { const float a = x1[i], b = x2[i]; x1[i] = a * cs[i] - b * sn[i]; x2[i] = b * cs[i] + a * sn[i]; }
}

DI int tokp(int tok) { return (tok & ~31) | (((tok >> 2) & 3) << 3) | (((tok >> 4) & 1) << 2) | (tok & 3); }
DI void prep_src(int it, int& blk, int& kind, int& h, int& cb) {
    blk = it >> 2; const int hs = it & 3;
    if (hs < 2) { kind = 1; h = hs; cb = C_KA; } else { kind = 2; h = hs - 2; cb = C_VA; }
    cb += h * 128;
}
DI void ph_prep(const Frame& F0, int l) { const Frame F = launder(F0);
    LAS unsigned char* T = F.lds;
    const int t = F.tid, tok = t >> 2, q = t & 3;
    const float* kg = F.a->in[I_KG] + l * HD;
    f32x4 kgv[4][2];
#pragma unroll
    for (int c = 0; c < 4; ++c) { kgv[c][0] = *(const f32x4*)(kg + 32 * c + 8 * q); kgv[c][1] = *(const f32x4*)(kg + 32 * c + 8 * q + 4); }
    const int NIT = NBLK * 4;
    v4u cur[4];
    { int blk, kind, h, cb; if (F.bx < NIT) { prep_src(F.bx, blk, kind, h, cb); const bf16* rp = FW(bf16, WS_PROJ) + (size_t)(blk * 128 + tok) * INC + cb + 8 * q;
#pragma unroll
        for (int c = 0; c < 4; ++c) cur[c] = *(const GAS v4u*)(rp + 32 * c); } }
    for (int it = F.bx; it < NIT; it += F.G) {
        int blk, kind, h, cb; prep_src(it, blk, kind, h, cb); const bool lat = blk < 128;
        const int row = blk * 128 + tok;
        bf16* rp = FW(bf16, WS_PROJ) + (size_t)row * INC + cb + 8 * q;
        v4u nxt[4];
        if (it + F.G < NIT) { int b2, k2, h2, c2; prep_src(it + F.G, b2, k2, h2, c2); const bf16* rp2 = FW(bf16, WS_PROJ) + (size_t)(b2 * 128 + tok) * INC + c2 + 8 * q;
#pragma unroll
            for (int c = 0; c < 4; ++c) nxt[c] = *(const GAS v4u*)(rp2 + 32 * c); }
        v4u w[4];
        if (kind == 1) {
            float v[4][8];
#pragma unroll
            for (int c = 0; c < 4; ++c) unpk8(cur[c], v[c]);
            {
                float ss = 0.f;
#pragma unroll
                for (int c = 0; c < 4; ++c)
#pragma unroll
                    for (int i = 0; i < 8; ++i) ss += v[c][i] * v[c][i];
                ss += __shfl_xor(ss, 1); ss += __shfl_xor(ss, 2);
                const float rstd = 1.f / sqrtf(ss * (1.f / HD) + EPS);
#pragma unroll
                for (int c = 0; c < 4; ++c) { const float gg[8] = {kgv[c][0].x, kgv[c][0].y, kgv[c][0].z, kgv[c][0].w, kgv[c][1].x, kgv[c][1].y, kgv[c][1].z, kgv[c][1].w};
#pragma unroll
                    for (int i = 0; i < 8; ++i) v[c][i] *= rstd * gg[i]; }
            }
            if (lat) { rope8(v[0], v[1], FW(float, WS_ROPE) + (row >> 6) * 32 + 8 * q); rope8(v[2], v[3], FW(float, WS_ROPE) + (row & 63) * 32 + 8 * q); }
#pragma unroll
            for (int c = 0; c < 4; ++c) { w[c] = pk8(v[c]); *(GAS v4u*)(rp + 32 * c) = w[c]; }
        } else {
#pragma unroll
            for (int c = 0; c < 4; ++c) w[c] = cur[c];
        }
        if (kind != 1) {
#pragma unroll
            for (int c = 0; c < 4; ++c) { const unsigned ww[4] = {w[c].x, w[c].y, w[c].z, w[c].w};
#pragma unroll
                for (int i = 0; i < 8; ++i) *(LAS bf16*)(T + (32 * c + 8 * q + i) * 272 + tokp(tok) * 2) = (bf16)((i & 1) ? (ww[i >> 1] >> 16) : (ww[i >> 1] & 0xffffu)); }
            __syncthreads();
            bf16* dst = FW(bf16, WS_VAT) + (size_t)(blk * 2 + h) * 16384;
#pragma unroll
            for (int k = 0; k < 4; ++k) { const int id = t + 512 * k, d = id >> 4, tc = id & 15; const v4u x = *(const LAS v4u*)(T + d * 272 + tc * 16); *(GAS v4u*)(dst + d * 128 + tc * 8) = x; }
            __syncthreads();
        }
#pragma unroll
        for (int c = 0; c < 4; ++c) cur[c] = nxt[c];
    }
    __syncthreads();
}

DI int attn_tile_blk(int b, int ti) { return ti < 2 ? 128 + ti : b - 1 + (ti - 2); }
DI bool attn_tile_valid(int b, int ti) { if (ti < 2) return true; const int kb = b - 1 + (ti - 2); return kb >= 0 && kb < 128; }
DI void attn_load(const Frame& F, int b, int kvh, int ti, v4u (&kr)[4], v4u (&vr)[4]) {
    const int kb = attn_tile_blk(b, ti);
#pragma unroll
    for (int i = 0; i < 4; ++i) { const int id = F.tid + 512 * i, key = id >> 4, dc = id & 15; kr[i] = *(const GAS v4u*)(FW(bf16, WS_PROJ) + (size_t)(kb * 128 + key) * INC + C_KA + kvh * 128 + dc * 8); }
#pragma unroll
    for (int i = 0; i < 4; ++i) { const int id = F.tid + 512 * i, d = id >> 4, kc = id & 15; vr[i] = *(const GAS v4u*)(FW(bf16, WS_VAT) + ((size_t)(kb * 2 + kvh) * 128 + d) * 128 + kc * 8); }
}
DI void attn_item(const Frame& F0, int l, int b, int kvh, int pair, float m2) { const Frame F = launder(F0);
    const int w = F.wave, lane = F.lane, fr = lane & 15, fq = lane >> 4;
    LAS unsigned char* Ks = F.lds; LAS unsigned char* Vs = F.lds + 34816;
    const int head = kvh * 4 + pair * 2 + (w >> 2);
    const int qrow0 = b * 128 + (w & 3) * 32;
    bf16x8 Q[2][4];
    const float c1 = 0.08838834764831845f * 1.44269504089f;
    { const float* qg = F.a->in[I_QG] + l * HD;
#pragma unroll
      for (int qt = 0; qt < 2; ++qt) { const int row = qrow0 + qt * 16 + fr; float v[4][8]; float ss = 0.f;
#pragma unroll
        for (int ks = 0; ks < 4; ++ks) { unpk8(*(const GAS v4u*)(FW(bf16, WS_PROJ) + (size_t)row * INC + C_QA + head * 128 + ks * 32 + fq * 8), v[ks]);
#pragma unroll
            for (int i = 0; i < 8; ++i) ss += v[ks][i] * v[ks][i]; }
        ss += __shfl_xor(ss, 16); ss += __shfl_xor(ss, 32);
        const float rs = c1 / sqrtf(ss * (1.f / HD) + EPS);
#pragma unroll
        for (int ks = 0; ks < 4; ++ks) { const f32x4 g0 = *(const f32x4*)(qg + ks * 32 + fq * 8), g1 = *(const f32x4*)(qg + ks * 32 + fq * 8 + 4); const float gg[8] = {g0.x, g0.y, g0.z, g0.w, g1.x, g1.y, g1.z, g1.w};
#pragma unroll
            for (int i = 0; i < 8; ++i) v[ks][i] *= rs * gg[i]; }
        if (b < 128) { rope8(v[0], v[1], FW(float, WS_ROPE) + (row >> 6) * 32 + 8 * fq); rope8(v[2], v[3], FW(float, WS_ROPE) + (row & 63) * 32 + 8 * fq); }
#pragma unroll
        for (int ks = 0; ks < 4; ++ks) Q[qt][ks] = __builtin_bit_cast(bf16x8, pk8(v[ks])); } }
    f32x4 O[8][2];
#pragma unroll
    for (int dt = 0; dt < 8; ++dt) { O[dt][0] = (f32x4){0.f, 0.f, 0.f, 0.f}; O[dt][1] = O[dt][0]; }
    float ls[2] = {0.f, 0.f};
    const int nt = b >= 128 ? 2 : 5;
    v4u kr[4], vr[4];
    if (w & 1) __builtin_amdgcn_s_setprio(2);
    int ti = 0; attn_load(F, b, kvh, 0, kr, vr);
    for (;;) {
#pragma unroll
        for (int i = 0; i < 4; ++i) { const int id = F.tid + 512 * i; const int lo = (id >> 4) * 272 + (id & 15) * 16; *(LAS v4u*)(Ks + lo) = kr[i]; *(LAS v4u*)(Vs + lo) = vr[i]; }
        int nx = ti + 1; while (nx < nt && !attn_tile_valid(b, nx)) ++nx;
        __syncthreads();
        if (nx < nt) attn_load(F, b, kvh, nx, kr, vr);
        const int kstart = attn_tile_blk(b, ti) * 128;
        const bool edge = ti == 2 || ti == 4;
#pragma nounroll
        for (int hf = 0; hf < 2; ++hf) {
            f32x4 S[4][2];
#pragma unroll
            for (int kt = 0; kt < 4; ++kt) { S[kt][0] = (f32x4){-m2, -m2, -m2, -m2}; S[kt][1] = S[kt][0]; }
#pragma unroll
            for (int ks = 0; ks < 4; ++ks)
#pragma unroll
                for (int kt = 0; kt < 4; ++kt) { const bf16x8 kf = *(const LAS bf16x8*)(Ks + (64 * hf + 16 * kt + fr) * 272 + ks * 64 + fq * 16);
                    S[kt][0] = MFMA16(kf, Q[0][ks], S[kt][0]); S[kt][1] = MFMA16(kf, Q[1][ks], S[kt][1]); }
            if (edge) {
#pragma unroll
                for (int qt = 0; qt < 2; ++qt) { const int qpos = qrow0 + qt * 16 + fr;
#pragma unroll
                    for (int kt = 0; kt < 4; ++kt)
#pragma unroll
                        for (int rg = 0; rg < 4; ++rg) { float p = ex2(S[kt][qt][rg]); const int dd = qpos - (kstart + 64 * hf + 16 * kt + 4 * fq + rg); if (dd > 128 || dd < -128) p = 0.f; S[kt][qt][rg] = p; ls[qt] += p; } }
            } else {
#pragma unroll
                for (int qt = 0; qt < 2; ++qt)
#pragma unroll
                    for (int kt = 0; kt < 4; ++kt)
#pragma unroll
                        for (int rg = 0; rg < 4; ++rg) { const float p = ex2(S[kt][qt][rg]); S[kt][qt][rg] = p; ls[qt] += p; }
            }
            bf16x8 P[2][2];
#pragma unroll
            for (int qt = 0; qt < 2; ++qt)
#pragma unroll
                for (int s2 = 0; s2 < 2; ++s2) { v4u pw; pw.x = pk2(S[2 * s2][qt][0], S[2 * s2][qt][1]); pw.y = pk2(S[2 * s2][qt][2], S[2 * s2][qt][3]);
                    pw.z = pk2(S[2 * s2 + 1][qt][0], S[2 * s2 + 1][qt][1]); pw.w = pk2(S[2 * s2 + 1][qt][2], S[2 * s2 + 1][qt][3]); P[qt][s2] = __builtin_bit_cast(bf16x8, pw); }
#pragma unroll
            for (int s2 = 0; s2 < 2; ++s2)
#pragma unroll
                for (int dt = 0; dt < 8; ++dt) { const bf16x8 vf = *(const LAS bf16x8*)(Vs + (16 * dt + fr) * 272 + (64 * hf + 32 * s2 + 8 * fq) * 2);
                    O[dt][0] = MFMA16(vf, P[0][s2], O[dt][0]); O[dt][1] = MFMA16(vf, P[1][s2], O[dt][1]); }
        }
        __syncthreads();
        if (nx >= nt) break;
        ti = nx;
    }
    __builtin_amdgcn_s_setprio(0);
    const float sk = F.a->in[I_SINK][l * 8 + head];
#pragma unroll
    for (int qt = 0; qt < 2; ++qt) { float s = ls[qt]; s += __shfl_xor(s, 16); s += __shfl_xor(s, 32); const float inv = 1.f / (s + ex2(sk * 1.44269504089f - m2));
        bf16* op = FW(bf16, WS_MIX) + (size_t)(qrow0 + qt * 16 + fr) * DM + head * 128 + 4 * fq;
#pragma unroll
        for (int dt = 0; dt < 8; ++dt) { const f32x4 o = O[dt][qt] * inv; v2u wv; wv.x = pk2(o.x, o.y); wv.y = pk2(o.z, o.w); *(GAS v2u*)(op + 16 * dt) = wv; } }
}

DI void fkv_load(const Frame& F, int it, v4u (&kc)[4], v4u (&vc)[4]) {
    const int cz = it >> 3, h = it & 7, tok = F.tid >> 2, q = F.tid & 3; const bf16* rp = FW(bf16, WS_PROJ) + (size_t)(cz * 128 + tok) * INC + h * 128 + 8 * q;
#pragma unroll
    for (int c = 0; c < 4; ++c) { kc[c] = *(const GAS v4u*)(rp + C_KR + 32 * c); vc[c] = *(const GAS v4u*)(rp + C_VR + 32 * c); }
}
DI void fkv_item(const Frame& F0, int cz, int h, float lgf2, float lgb2, int nxt, v4u (&kc)[4], v4u (&vc)[4]) { const Frame F = launder(F0);
    const int w = F.wave, lane = F.lane, fr = lane & 15, fq = lane >> 4, t = F.tid, tok = t >> 2, q = t & 3;
    LAS unsigned char* T1 = F.lds; LAS unsigned char* T2 = F.lds + 34816;
    const int row = cz * 128 + tok;
    { float v[4][8];
#pragma unroll
      for (int c = 0; c < 4; ++c) unpk8(kc[c], v[c]);
      if (cz < 128) { rope8(v[0], v[1], FW(float, WS_ROPE) + (row >> 6) * 32 + 8 * q); rope8(v[2], v[3], FW(float, WS_ROPE) + (row & 63) * 32 + 8 * q); }
      bf16* rp = FW(bf16, WS_PROJ) + (size_t)row * INC + C_KR + h * 128 + 8 * q;
#pragma unroll
      for (int c = 0; c < 4; ++c) {
#pragma unroll
          for (int i = 0; i < 8; ++i) v[c][i] *= 0.08838834764831845f;
          const v4u kw = pk8(v[c]); *(GAS v4u*)(rp + 32 * c) = kw;
          const unsigned k4[4] = {kw.x, kw.y, kw.z, kw.w}, v4[4] = {vc[c].x, vc[c].y, vc[c].z, vc[c].w};
#pragma unroll
          for (int i = 0; i < 8; ++i) { const int d = 32 * c + 8 * q + i;
              *(LAS bf16*)(T1 + d * 272 + tokp(tok) * 2) = (bf16)((i & 1) ? (k4[i >> 1] >> 16) : (k4[i >> 1] & 0xffffu));
              *(LAS bf16*)(T2 + d * 272 + tokp(tok) * 2) = (bf16)((i & 1) ? (v4[i >> 1] >> 16) : (v4[i >> 1] & 0xffffu)); } } }
    __syncthreads();
    if (nxt >= 0) fkv_load(F, nxt, kc, vc);
    { bf16* dst = FW(bf16, WS_VRT) + (size_t)(cz * 8 + h) * 16384;
#pragma unroll
      for (int k = 0; k < 4; ++k) { const int id = t + 512 * k, d = id >> 4, tc = id & 15; *(GAS v4u*)(dst + d * 128 + tc * 8) = *(const LAS v4u*)(T2 + d * 272 + tc * 16); } }
    bf16x8 Xf[4], Xb[4];
#pragma unroll
    for (int ks = 0; ks < 4; ++ks) { const v4u x = *(const LAS v4u*)(T2 + (16 * w + fr) * 272 + (32 * ks + 8 * fq) * 2); const unsigned xw[4] = {x.x, x.y, x.z, x.w}; v4u of, ob; unsigned rf[4], rb[4];
#pragma unroll
        for (int i = 0; i < 4; ++i) { const int j = 32 * ks + 16 * (i >> 1) + 4 * fq + 2 * (i & 1); const float a = bflo(xw[i]), b = bfhi(xw[i]);
            rf[i] = pk2(a * ex2((float)(127 - j) * lgf2), b * ex2((float)(126 - j) * lgf2)); rb[i] = pk2(a * ex2((float)j * lgb2), b * ex2((float)(j + 1) * lgb2)); }
        of.x = rf[0]; of.y = rf[1]; of.z = rf[2]; of.w = rf[3]; ob.x = rb[0]; ob.y = rb[1]; ob.z = rb[2]; ob.w = rb[3];
        Xf[ks] = __builtin_bit_cast(bf16x8, of); Xb[ks] = __builtin_bit_cast(bf16x8, ob); }
    f32x4 af[8], ab[8];
#pragma unroll
    for (int dt = 0; dt < 8; ++dt) { af[dt] = (f32x4){0.f, 0.f, 0.f, 0.f}; ab[dt] = af[dt]; }
#pragma unroll
    for (int ks = 0; ks < 4; ++ks)
#pragma unroll
        for (int dt = 0; dt < 8; ++dt) { const bf16x8 yf = *(const LAS bf16x8*)(T1 + (16 * dt + fr) * 272 + ks * 64 + fq * 16); af[dt] = MFMA16(yf, Xf[ks], af[dt]); ab[dt] = MFMA16(yf, Xb[ks], ab[dt]); }
    bf16* o = FW(bf16, WS_KV) + ((size_t)((cz * 8 + h) * 2) * 128 + 16 * w + fr) * 128 + 4 * fq;
#pragma unroll
    for (int dt = 0; dt < 8; ++dt) { v2u a, b; a.x = pk2_safe(af[dt].x, af[dt].y); a.y = pk2_safe(af[dt].z, af[dt].w); b.x = pk2_safe(ab[dt].x, ab[dt].y); b.y = pk2_safe(ab[dt].z, ab[dt].w);
        *(GAS v2u*)(o + 16 * dt) = a; *(GAS v2u*)(o + 16384 + 16 * dt) = b; }
    __syncthreads();
}
DI float log2_gamma(const Frame& F, int l, int dir, int h) { const float x = F.a->in[I_DECAY][(l * 2 + dir) * 8 + h]; return -log1pf(expf(-x)) * 1.44269504089f; }

DI void ph_prep_kv(const Frame& F0, int l) { const Frame F = launder(F0);
    ph_prep(F0, l);
    const int NKV = NBLK * 8;
    v4u kc[4], vc[4];
    int it = F.G - 1 - F.bx;
    if (it < NKV) fkv_load(F, it, kc, vc);
    for (; it < NKV; it += F.G) { const int cz = it >> 3, h = it & 7; fkv_item(F0, cz, h, log2_gamma(F, l, 0, h), log2_gamma(F, l, 1, h), it + F.G < NKV ? it + F.G : -1, kc, vc); }
    __syncthreads();
}

DI void scan_share(const Frame& F0, int l, int s, int SG) { const Frame F = launder(F0);
    for (int idx = s * NTHR + F.tid; idx < 131072; idx += 2 * SG * NTHR) {
        const int idx2 = idx + SG * NTHR; const bool two = idx2 < 131072; const int jdx = two ? idx2 : idx;
        const int h = idx >> 14, dir = (idx >> 13) & 1, h2 = jdx >> 14, dir2 = (jdx >> 13) & 1;
        const float dec = ex2(128.f * log2_gamma(F, l, dir, h)), dec2 = ex2(128.f * log2_gamma(F, l, dir2, h2));
        const size_t base = ((size_t)(h * 2 + dir) * 128 + ((idx >> 6) & 127)) * 128 + (idx & 63) * 2, base2 = ((size_t)(h2 * 2 + dir2) * 128 + ((jdx >> 6) & 127)) * 128 + (jdx & 63) * 2;
        float s0 = 0.f, s1 = 0.f, t0 = 0.f, t1 = 0.f;
        for (int st = 0; st < 130; st += 10) {
            unsigned kv[10], kw[10];
#pragma unroll
            for (int u = 0; u < 10; ++u) { const int step = st + u; const int cz = dir ? 129 - step : (step < 2 ? 128 + step : step - 2), cz2 = dir2 ? 129 - step : (step < 2 ? 128 + step : step - 2);
                kv[u] = *(const GAS unsigned*)(FW(bf16, WS_KV) + (size_t)cz * 262144 + base); kw[u] = *(const GAS unsigned*)(FW(bf16, WS_KV) + (size_t)cz2 * 262144 + base2); }
#pragma unroll
            for (int u = 0; u < 10; ++u) { const int step = st + u; const int cz = dir ? 129 - step : (step < 2 ? 128 + step : step - 2), cz2 = dir2 ? 129 - step : (step < 2 ? 128 + step : step - 2);
                *(GAS unsigned*)(FW(bf16, WS_SPREV) + (size_t)cz * 262144 + base) = pk2(s0, s1); s0 = dec * s0 + bflo(kv[u]); s1 = dec * s1 + bfhi(kv[u]);
                if (two) { *(GAS unsigned*)(FW(bf16, WS_SPREV) + (size_t)cz2 * 262144 + base2) = pk2(t0, t1); t0 = dec2 * t0 + bflo(kw[u]); t1 = dec2 * t1 + bfhi(kw[u]); } }
        }
    }
}

DI void ld_tile128(LAS unsigned char* dst, const bf16* src, int pitch_elems, int tid) {
#pragma unroll
    for (int k = 0; k < 4; ++k) { const int id = tid + 512 * k, r = id >> 4, c = id & 15; *(LAS v4u*)(dst + r * 272 + c * 16) = *(const GAS v4u*)(src + (size_t)r * pitch_elems + c * 8); }
}
DI void ret_ld_pair(const bf16* a, int pa, const bf16* b, int pb, int tid, v4u (&R)[8]) {
#pragma unroll
    for (int k = 0; k < 4; ++k) { const int id = tid + 512 * k, r = id >> 4, c = id & 15; R[k] = *(const GAS v4u*)(a + (size_t)r * pa + c * 8); R[4 + k] = *(const GAS v4u*)(b + (size_t)r * pb + c * 8); }
}
DI void ret_st_pair(LAS unsigned char* A, LAS unsigned char* B, int tid, const v4u (&R)[8]) {
#pragma unroll
    for (int k = 0; k < 4; ++k) { const int id = tid + 512 * k, r = id >> 4, c = id & 15; const int lo = r * 272 + c * 16; *(LAS v4u*)(A + lo) = R[k]; *(LAS v4u*)(B + lo) = R[4 + k]; }
}
DI void ret_ld_state(const Frame& F, int it, v4u (&R)[8]) { const int cz = it >> 3, h = it & 7; const bf16* s2 = FW(bf16, WS_SPREV) + (size_t)cz * 262144 + (size_t)(h * 2) * 16384; ret_ld_pair(s2, 128, s2 + 16384, 128, F.tid, R); }
DI void ret_ld_kv(const Frame& F, int it, v4u (&R)[8]) { const int cz = it >> 3, h = it & 7; ret_ld_pair(FW(bf16, WS_PROJ) + (size_t)(cz * 128) * INC + C_KR + h * 128, INC, FW(bf16, WS_VRT) + (size_t)(cz * 8 + h) * 16384, 128, F.tid, R); }
DI void ret_item(const Frame& F0, int l, int it, int nxt, v4u (&R)[8]) { const Frame F = launder(F0);
    const int w = F.wave, lane = F.lane, fr = lane & 15, fq = lane >> 4;
    LAS unsigned char* Kn = F.lds; LAS unsigned char* Vt = F.lds + 34816; LAS unsigned char* Sf = F.lds + 2 * 34816; LAS unsigned char* Sb = F.lds + 3 * 34816;
    const int cz = it >> 3, h = it & 7, row0 = cz * 128;
    const float lgf2 = log2_gamma(F, l, 0, h), lgb2 = log2_gamma(F, l, 1, h);
    const int i = 16 * w + fr;
    const bf16* qp = FW(bf16, WS_PROJ) + (size_t)(row0 + i) * INC;
    bf16x8 Qf[4];
    { v4u qw[4];
#pragma unroll
      for (int ks = 0; ks < 4; ++ks) qw[ks] = *(const GAS v4u*)(qp + C_QR + h * 128 + 32 * ks + 8 * fq);
      if (nxt >= 0) ret_ld_state(F, nxt, R);
      if (cz < 128) { float v[4][8];
#pragma unroll
        for (int ks = 0; ks < 4; ++ks) unpk8(qw[ks], v[ks]);
        const int row = row0 + i; rope8(v[0], v[1], FW(float, WS_ROPE) + (row >> 6) * 32 + 8 * fq); rope8(v[2], v[3], FW(float, WS_ROPE) + (row & 63) * 32 + 8 * fq);
#pragma unroll
        for (int ks = 0; ks < 4; ++ks) qw[ks] = pk8(v[ks]); }
#pragma unroll
      for (int ks = 0; ks < 4; ++ks) Qf[ks] = __builtin_bit_cast(bf16x8, qw[ks]); }
    f32x4 Y[8];
    { f32x4 CF[8], CB[8];
#pragma unroll
      for (int et = 0; et < 8; ++et) { CF[et] = (f32x4){0.f, 0.f, 0.f, 0.f}; CB[et] = CF[et]; }
#pragma unroll
      for (int ks = 0; ks < 4; ++ks) { bf16x8 sfv[8], sbv[8];
#pragma unroll
        for (int et = 0; et < 8; ++et) { sfv[et] = *(const LAS bf16x8*)(Sf + (16 * et + fr) * 272 + ks * 64 + fq * 16); sbv[et] = *(const LAS bf16x8*)(Sb + (16 * et + fr) * 272 + ks * 64 + fq * 16); }
        __builtin_amdgcn_sched_barrier(0);
#pragma unroll
        for (int et = 0; et < 8; ++et) { CF[et] = MFMA16(sfv[et], Qf[ks], CF[et]); CB[et] = MFMA16(sbv[et], Qf[ks], CB[et]); }
        __builtin_amdgcn_sched_barrier(0); }
      const float cf = ex2((float)(i + 1) * lgf2), cb = ex2((float)(128 - i) * lgb2);
#pragma unroll
      for (int et = 0; et < 8; ++et) Y[et] = cf * CF[et] + cb * CB[et];
    }
    __syncthreads();
    if (nxt >= 0) { ret_st_pair(Sf, Sb, F.tid, R); ret_ld_kv(F, nxt, R); }
    f32x4 S[8];
#pragma unroll
    for (int jt = 0; jt < 8; ++jt) S[jt] = (f32x4){0.f, 0.f, 0.f, 0.f};
#pragma unroll
    for (int ks = 0; ks < 4; ks += 2) { bf16x8 kfv[2][8];
#pragma unroll
        for (int k2 = 0; k2 < 2; ++k2)
#pragma unroll
            for (int jt = 0; jt < 8; ++jt) kfv[k2][jt] = *(const LAS bf16x8*)(Kn + (16 * jt + fr) * 272 + (ks + k2) * 64 + fq * 16);
        __builtin_amdgcn_sched_barrier(0);
#pragma unroll
        for (int k2 = 0; k2 < 2; ++k2)
#pragma unroll
            for (int jt = 0; jt < 8; ++jt) S[jt] = MFMA16(kfv[k2][jt], Qf[ks + k2], S[jt]);
        __builtin_amdgcn_sched_barrier(0); }
#pragma unroll
    for (int jt = 0; jt < 8; ++jt)
#pragma unroll
        for (int rg = 0; rg < 4; ++rg) { const int dl = i - (16 * jt + 4 * fq + rg); const float wgt = dl > 0 ? ex2((float)dl * lgf2) : (dl < 0 ? ex2((float)(-dl) * lgb2) : 2.f); S[jt][rg] *= wgt; }
    bf16x8 P[4];
#pragma unroll
    for (int s4 = 0; s4 < 4; ++s4) { v4u pw; pw.x = pk2(S[2 * s4][0], S[2 * s4][1]); pw.y = pk2(S[2 * s4][2], S[2 * s4][3]); pw.z = pk2(S[2 * s4 + 1][0], S[2 * s4 + 1][1]); pw.w = pk2(S[2 * s4 + 1][2], S[2 * s4 + 1][3]);
        P[s4] = __builtin_bit_cast(bf16x8, pw); }
#pragma unroll
    for (int s4 = 0; s4 < 4; s4 += 2) { bf16x8 vfv[2][8];
#pragma unroll
        for (int k2 = 0; k2 < 2; ++k2)
#pragma unroll
            for (int et = 0; et < 8; ++et) vfv[k2][et] = *(const LAS bf16x8*)(Vt + (16 * et + fr) * 272 + (32 * (s4 + k2) + 8 * fq) * 2);
        __builtin_amdgcn_sched_barrier(0);
#pragma unroll
        for (int k2 = 0; k2 < 2; ++k2)
#pragma unroll
            for (int et = 0; et < 8; ++et) Y[et] = MFMA16(vfv[k2][et], P[s4 + k2], Y[et]);
        __builtin_amdgcn_sched_barrier(0); }
    float sum = 0.f;
#pragma unroll
    for (int et = 0; et < 8; ++et) sum += (Y[et].x + Y[et].y) + (Y[et].z + Y[et].w);
    sum += __shfl_xor(sum, 16); sum += __shfl_xor(sum, 32);
    const float mu = sum * (1.f / HD); float var = 0.f;
#pragma unroll
    for (int et = 0; et < 8; ++et) { Y[et] = Y[et] - mu; var += (Y[et].x * Y[et].x + Y[et].y * Y[et].y) + (Y[et].z * Y[et].z + Y[et].w * Y[et].w); }
    var += __shfl_xor(var, 16); var += __shfl_xor(var, 32);
    const float rstd = 1.f / sqrtf(var * (1.f / HD) + EPS);
    const float* gn = F.a->in[I_GNG] + (size_t)(l * 8 + h) * HD + 4 * fq;
    bf16* op = FW(bf16, WS_MIX) + (size_t)(row0 + i) * DM + 1024 + h * 128 + 4 * fq;
    v2u gwv[8]; f32x4 ggv[8];
#pragma unroll
    for (int et = 0; et < 8; ++et) { gwv[et] = *(const GAS v2u*)(qp + C_GR + h * 128 + 16 * et + 4 * fq); ggv[et] = *(const GAS f32x4*)(gn + 16 * et); }
#pragma unroll
    for (int et = 0; et < 8; ++et) { const v2u gw = gwv[et]; const f32x4 gg = ggv[et];
        const float g0 = bflo(gw.x), g1 = bfhi(gw.x), g2 = bflo(gw.y), g3 = bfhi(gw.y);
        const float o0 = g0 * __builtin_amdgcn_rcpf(1.f + ex2(-1.44269504089f * g0)) * (Y[et].x * rstd * gg.x), o1 = g1 * __builtin_amdgcn_rcpf(1.f + ex2(-1.44269504089f * g1)) * (Y[et].y * rstd * gg.y);
        const float o2 = g2 * __builtin_amdgcn_rcpf(1.f + ex2(-1.44269504089f * g2)) * (Y[et].z * rstd * gg.z), o3 = g3 * __builtin_amdgcn_rcpf(1.f + ex2(-1.44269504089f * g3)) * (Y[et].w * rstd * gg.w);
        v2u wv; wv.x = pk2(o0, o1); wv.y = pk2(o2, o3); *(GAS v2u*)(op + 16 * et) = wv; }
    __syncthreads();
    if (nxt >= 0) ret_st_pair(Kn, Vt, F.tid, R);
    __syncthreads();
}
DI void ret_ctx_item(const Frame& F0, int l, int it) { const Frame F = launder(F0);
    LAS unsigned char* Kn = F.lds; LAS unsigned char* Vt = F.lds + 34816; LAS unsigned char* Sf = F.lds + 2 * 34816; LAS unsigned char* Sb = F.lds + 3 * 34816;
    const int cz = it >> 3, h = it & 7; v4u R[8];
    const bf16* zero = FW(bf16, WS_CTL + 512 * 1024);
    const bf16* sf = cz == 128 ? zero : FW(bf16, WS_KV) + (size_t)128 * 262144 + (size_t)(h * 2) * 16384;
    const bf16* sb = cz == 129 ? zero : FW(bf16, WS_KV) + (size_t)129 * 262144 + (size_t)(h * 2 + 1) * 16384;
    ret_ld_pair(sf, 128, sb, 128, F.tid, R); ret_st_pair(Sf, Sb, F.tid, R); ret_ld_kv(F, it, R); ret_st_pair(Kn, Vt, F.tid, R);
    __syncthreads();
    ret_item(F0, l, it, -1, R);
    __syncthreads();
}
DI void ph_attn_scan(const Frame& F0, int l) { const Frame F = launder(F0);
    LAS float* scf = (LAS float*)(F.lds + SCR_OFF);
    if (F.wave == 0) { const float* qg = F.a->in[I_QG] + l * HD; const float* kg = F.a->in[I_KG] + l * HD;
        float a = fmaxf(fabsf(qg[F.lane]), fabsf(qg[F.lane + 64])), b = fmaxf(fabsf(kg[F.lane]), fabsf(kg[F.lane + 64]));
        float s = F.lane < 8 ? F.a->in[I_SINK][l * 8 + F.lane] : -3.0e38f;
#pragma unroll
        for (int o = 1; o < 64; o <<= 1) { a = fmaxf(a, __shfl_xor(a, o)); b = fmaxf(b, __shfl_xor(b, o)); s = fmaxf(s, __shfl_xor(s, o)); }
        if (F.lane == 0) scf[0] = fmaxf(11.313708499f * a * b * 1.03f, s) * 1.44269504089f; }
    __syncthreads();
    const float m2 = scf[0];
    const int NX = (l == 0 && F.G >= 64) ? 24 : 0;
    const bool scans = F.bx >= NX, scan_first = ((F.bx >> 3) & 1) == 0;
    if (scans && scan_first) scan_share(F0, l, F.bx - NX, F.G - NX);
    const int NA = 512 + (l == 0 ? 8 : 0);
    for (int it = F.bx; it < NA; it += F.G) { const int b = it < 512 ? (it >> 2) : 128 + ((it - 512) >> 2), kvh = (it >> 1) & 1, pair = it & 1; attn_item(F, l, b, kvh, pair, m2); }
    __syncthreads();
    if (NX) { if (F.bx >= 8 && F.bx < 24) ret_ctx_item(F0, l, 1024 + F.bx - 8); }
    if (scans && !scan_first) scan_share(F0, l, F.bx - NX, F.G - NX);
}
DI void ph_retout(const Frame& F0, int l) { const Frame F = launder(F0);
    const int NI = (l == 0 && F.G < 64 ? NBLK : 128) * 8;
    LAS unsigned char* Kn = F.lds; LAS unsigned char* Vt = F.lds + 34816; LAS unsigned char* Sf = F.lds + 2 * 34816; LAS unsigned char* Sb = F.lds + 3 * 34816;
    v4u R[8];
    int it = F.bx;
    if (it < NI) { ret_ld_state(F, it, R); ret_st_pair(Sf, Sb, F.tid, R); ret_ld_kv(F, it, R); ret_st_pair(Kn, Vt, F.tid, R); }
    __syncthreads();
    for (; it < NI; it += F.G) ret_item(F0, l, it, it + F.G < NI ? it + F.G : -1, R);
}

DI void ph_gather(const Frame& F0) { const Frame F = launder(F0);
    LAS int* sc = (LAS int*)(F.lds + SCR_OFF);
    const int* RBCNT = (const int*)(F.a->ws + WS_RBCNT); const v4u* SEL = (const v4u*)(F.a->ws + WS_SEL); int* TOKSLOT = (int*)(F.a->ws + WS_TOKSLOT); int* PTAB = (int*)(F.a->ws + WS_PTAB);
    int* SLOTTOK = (int*)(F.a->ws + WS_SLOTTOK); float* SLOTG = (float*)(F.a->ws + WS_SLOTG);
    const int ge = F.tid & 7, gk = F.tid >> 3; int rc[4];
#pragma unroll
    for (int m = 0; m < 4; ++m) rc[m] = RBCNT[(gk + 64 * m) * 8 + ge];
    { int t = (rc[0] + rc[1]) + (rc[2] + rc[3]); t += __shfl_xor(t, 8); t += __shfl_xor(t, 16); t += __shfl_xor(t, 32); if (F.lane < 8) sc[32 + F.wave * 8 + F.lane] = t; }
    __syncthreads();
    if (F.tid < 8) { int t = 0; for (int w = 0; w < NWAVES; ++w) t += sc[32 + w * 8 + F.tid]; sc[F.tid] = t; }
    __syncthreads();
    if (F.tid == 0) { int r0 = 0, p = 0; for (int e = 0; e < 8; ++e) { sc[8 + e] = r0; const int np = (sc[e] + 255) >> 8; if (F.bx == 0) for (int k = 0; k < np; ++k) PTAB[1 + p + k] = e; p += np; r0 += np * 256; } if (F.bx == 0) PTAB[0] = p; }
    __syncthreads();
    if (F.bx < 8) { const int e = F.bx, lo = sc[8 + e] + sc[e], hi = sc[8 + e] + (((sc[e] + 255) >> 8) << 8); for (int s = lo + F.tid; s < hi; s += NTHR) { SLOTTOK[s] = -1; SLOTG[s] = 0.f; } }
    for (int rb = F.bx; rb < 256; rb += F.G) {
        { int t = 0;
#pragma unroll
          for (int m = 0; m < 4; ++m) t += (gk + 64 * m) < rb ? rc[m] : 0;
          t += __shfl_xor(t, 8); t += __shfl_xor(t, 16); t += __shfl_xor(t, 32); if (F.lane < 8) sc[96 + F.wave * 8 + F.lane] = t; }
        __syncthreads();
        if (F.tid < 8) { int b = sc[8 + F.tid]; for (int w = 0; w < NWAVES; ++w) b += sc[96 + w * 8 + F.tid]; sc[16 + F.tid] = b; sc[24 + F.tid] = 0; }
        __syncthreads();
        if (F.tid < 128) { const int t = rb * 64 + (F.tid >> 1), p = F.tid & 1; const v4u sv = SEL[t];
            const int e = p ? (int)((sv.x >> 8) & 0xffu) : (int)(sv.x & 0xffu); const int pos = __hip_atomic_fetch_add(sc + 24 + e, 1, __ATOMIC_RELAXED, __HIP_MEMORY_SCOPE_WORKGROUP);
            const int slot = sc[16 + e] + pos; TOKSLOT[t * 2 + p] = slot; SLOTTOK[slot] = t; SLOTG[slot] = __uint_as_float(p ? sv.z : sv.y); }
        __syncthreads();
    }
}
DI void load_ptab(const Frame& F0) { const Frame F = launder(F0); LAS int* tab = (LAS int*)(F.lds + SCR_OFF); const int* PTAB = (const int*)(F.a->ws + WS_PTAB); for (int i = F.tid; i < 1 + PMAX; i += NTHR) tab[i] = PTAB[i];
    if (F.tid < 24) tab[176 + F.tid] = (int)((const unsigned*)(F.a->ws + WS_CTL))[CW_AMAX + F.tid];
    __syncthreads();
    if (F.tid == 0) { const int P = tab[0]; int e = 0; tab[160] = 0; for (int p = 0; p < P; ++p) { while (e < tab[1 + p]) { ++e; tab[160 + e] = p; } } while (e < 8) { ++e; tab[160 + e] = P; } }
    __syncthreads(); }

DI void ph_combine(const Frame& F0) { const Frame F = launder(F0);
    const v4u* SEL = (const v4u*)(F.a->ws + WS_SEL); const int* TOKSLOT = (const int*)(F.a->ws + WS_TOKSLOT);
    const float* gate = FW(float, WS_MODS) + 24576 + 5 * 2048;
    const int gw = F.bx * NWAVES + F.wave, NGW = F.G * NWAVES;
    const int P = ((const int*)(F.a->ws + WS_PTAB))[0]; const int full = ((8 * P) / F.G) * F.G;
    const int T = 8 * P - full, sp = pg8::tail_splits(T, F.G), tcap = sp ? F.G / sp : 0;
    const float* PT = FW(float, WS_PT);
    LAS int* tl = (LAS int*)F.lds;
    for (int i = F.tid; i < P * 8; i += NTHR) tl[i] = pg8::moe_index(i >> 3, i & 7, P, 8) - full;
    __syncthreads();
    f32x4 gt[8];
#pragma unroll
    for (int j = 0; j < 8; ++j) gt[j] = *(const f32x4*)(gate + 4 * F.lane + 256 * j);
    for (int t0 = gw; t0 < SEQ; t0 += 2 * NGW) {
        int tk[2], sl[2][2]; float gg[2][2]; v2u xv[2][8], ya[2][8], yb[2][8];
#pragma unroll
        for (int u = 0; u < 2; ++u) { tk[u] = t0 + u * NGW < SEQ ? t0 + u * NGW : t0; const v4u sv = SEL[tk[u]]; gg[u][0] = __uint_as_float(sv.y); gg[u][1] = __uint_as_float(sv.z);
            sl[u][0] = TOKSLOT[tk[u] * 2]; sl[u][1] = TOKSLOT[tk[u] * 2 + 1]; }
#pragma unroll
        for (int u = 0; u < 2; ++u) {
            const GAS v2u* xb = (const GAS v2u*)(FW(bf16, WS_XB) + (size_t)tk[u] * DM) + F.lane;
            const GAS v2u* y0 = (const GAS v2u*)(FW(bf16, WS_YP) + (size_t)sl[u][0] * DM) + F.lane; const GAS v2u* y1 = (const GAS v2u*)(FW(bf16, WS_YP) + (size_t)sl[u][1] * DM) + F.lane;
#pragma unroll
            for (int j = 0; j < 8; ++j) { xv[u][j] = xb[64 * j]; ya[u][j] = y0[64 * j]; yb[u][j] = y1[64 * j]; } }
#pragma unroll
        for (int u = 0; u < 2; ++u) {
            if (u == 1 && t0 + NGW >= SEQ) break;
            GAS f32x4* xo = (GAS f32x4*)(F.a->out + (size_t)tk[u] * DM) + F.lane;
            const LAS int* tp0 = tl + (sl[u][0] >> 8) * 8; const LAS int* tp1 = tl + (sl[u][1] >> 8) * 8;
#pragma unroll
            for (int j = 0; j < 8; ++j) {
                f32x4 a = (f32x4){bflo(ya[u][j].x), bfhi(ya[u][j].x), bflo(ya[u][j].y), bfhi(ya[u][j].y)}, b = (f32x4){bflo(yb[u][j].x), bfhi(yb[u][j].x), bflo(yb[u][j].y), bfhi(yb[u][j].y)};
                if (sp) {
                    const int i0 = tp0[j], i1 = tp1[j];
                    if (i0 >= 0) { a = (f32x4){0.f, 0.f, 0.f, 0.f};
#pragma unroll
                        for (int q = 0; q < 6; ++q) { const int qs = q < sp ? q : 0; const f32x4 v = *(const GAS f32x4*)(PT + ((size_t)(qs * tcap + i0) * 256 + (sl[u][0] & 255)) * 256 + 4 * F.lane); a += q < sp ? v : (f32x4){0.f, 0.f, 0.f, 0.f}; } }
                    if (i1 >= 0) { b = (f32x4){0.f, 0.f, 0.f, 0.f};
#pragma unroll
                        for (int q = 0; q < 6; ++q) { const int qs = q < sp ? q : 0; const f32x4 v = *(const GAS f32x4*)(PT + ((size_t)(qs * tcap + i1) * 256 + (sl[u][1] & 255)) * 256 + 4 * F.lane); b += q < sp ? v : (f32x4){0.f, 0.f, 0.f, 0.f}; } } }
                const f32x4 x = (f32x4){bflo(xv[u][j].x), bfhi(xv[u][j].x), bflo(xv[u][j].y), bfhi(xv[u][j].y)};
                xo[64 * j] = x + gt[j] * (gg[u][0] * a + gg[u][1] * b); } }
    }
}

#ifndef PG8_SP2
#define PG8_SP2 true
#endif
#ifndef PG8_ALIGN
#define PG8_ALIGN true
#endif
#ifndef MK_MULTI
#define MK_MULTI 0
#endif
constexpr int NPHASE = 26;
#ifndef PHASE_MASK
#define PHASE_MASK 0xffffffffu
#endif
#define PHM(j) ((PHASE_MASK >> (j)) & 1u)
#define IN(k) (lo <= (k) && (k) < hi)
#ifndef DUP_PHASE
#define DUP_PHASE (-1)
#define DUP_N 1
#endif
#define NREP(k) (((k) == DUP_PHASE) ? DUP_N : 1)
#define SEAM(k) do { if ((lo <= (k) && (k) + 1 < hi) || rep_ + 1 < NREP(k)) xcd_barrier(bar); } while (0)

#ifndef CVQ_IN
#define CVQ_IN 16
#define CVQ_FF 0
#endif
constexpr int CV_NIN = 106 * NWAVES * CVQ_IN, CV_NFF = 212 * NWAVES * CVQ_FF, CV0 = CVT_NMOE - 2 * CV_NIN - CV_NFF;
static_assert(CV0 > 0, "quota");
template <int l> DI void layer_body(const Frame& F0, const XcdBarrier& bar, const int lo, const int hi) {

        const int pb = 2 + 12 * l;
        const int MR = (l == 0) ? NROW : SEQ;
        if (PHM(2) && IN(pb + 0)) for (int rep_ = 0; rep_ < NREP(pb + 0); ++rep_) { ph_norm(F0, l, 0, NROW / 64, false); SEAM(pb + 0); }
        if (PHM(3) && IN(pb + 1)) for (int rep_ = 0; rep_ < NREP(pb + 1); ++rep_) {
            const Frame F = launder(F0); pg8::Gemm g{FW(bf16, WS_H), FW(bf16, WS_WIN) + (size_t)l * INC * DM, NROW, INC, DM, DM}; pg8::StaticOrder S; S.init(NROW, INC, F.G, F.bx);
            pg8::EpiStoreBf16 E{FW(bf16, WS_PROJ), INC, 1 << 30};
            pg8::gemm_phase<pg8::EpiStoreBf16, pg8::StaticOrder, PG8_ALIGN, PG8_SP2>(F.lds, g, S, E);
            if (F.G == 256 && F.bx >= 150) { const int lo = l == 0 ? CV0 : CV0 + CV_NIN + CV_NFF; cvt_moe_range(F0, lo, lo + CV_NIN, (F.bx - 150) * NWAVES + F.wave, 106 * NWAVES); }
            SEAM(pb + 1);
        }
        if (PHM(4) && IN(pb + 2)) for (int rep_ = 0; rep_ < NREP(pb + 2); ++rep_) { ph_prep_kv(F0, l); SEAM(pb + 2); }
        if (PHM(5) && IN(pb + 3)) for (int rep_ = 0; rep_ < NREP(pb + 3); ++rep_) { ph_attn_scan(F0, l); SEAM(pb + 3); }
        if (PHM(7) && IN(pb + 5)) for (int rep_ = 0; rep_ < NREP(pb + 5); ++rep_) { ph_retout(F0, l); SEAM(pb + 5); }
        if (PHM(8) && IN(pb + 6)) for (int rep_ = 0; rep_ < NREP(pb + 6); ++rep_) {
            const Frame F = launder(F0); pg8::Gemm g{FW(bf16, WS_MIX), FW(bf16, WS_WOUT) + (size_t)l * DM * DM, SEQ, DM, DM, DM}; pg8::StaticOrder S; S.init(SEQ, DM, F.G, F.bx);
            const float* md = FW(float, WS_MODS) + (size_t)l * 24576;
            pg8::EpiResidB<l == 0> E{F.a->in[I_X], FW(bf16, WS_XB), md + 2 * 2048, DM};
            pg8::gemm_phase<pg8::EpiResidB<l == 0>, pg8::StaticOrder, PG8_ALIGN, PG8_SP2>(F.lds, g, S, E);
            if constexpr (l == 0) {
                const Frame F = launder(F0);
                pg8::Gemm g2{FW(bf16, WS_MIX), FW(bf16, WS_WOUT), NROW, DM, 256, DM}; pg8::SplitOrder S2{64, 8, 8, 256, F.G, F.bx};
                pg8::EpiPartial E2{FW(float, WS_PC1), 256, DM};
                pg8::gemm_phase<pg8::EpiPartial, pg8::SplitOrder, PG8_ALIGN, PG8_SP2>(F.lds, g2, S2, E2);
            }
            SEAM(pb + 6);
        }
        if (PHM(2) && IN(pb + 7)) for (int rep_ = 0; rep_ < NREP(pb + 7); ++rep_) { ph_norm(F0, l, 1, MR / 64, l == 1); SEAM(pb + 7); }
        if constexpr (l == 0) {
            if (PHM(9) && IN(pb + 8)) for (int rep_ = 0; rep_ < NREP(pb + 8); ++rep_) {
                const Frame F = launder(F0); pg8::Gemm g{FW(bf16, WS_H), FW(bf16, WS_WF13), NROW, 2 * DFF, DM, DM}; pg8::StaticOrder S; S.init(NROW, 2 * DFF, F.G, F.bx);
                const bool quad = (S.nwg % F.G) != 0 && 4 * (S.nwg % F.G) <= F.G;
                S.full_only = quad ? 1 : 0;
                pg8::EpiSwiglu E{FW(bf16, WS_U), DFF, 1 << 30};
                pg8::gemm_phase<pg8::EpiSwiglu, pg8::StaticOrder, PG8_ALIGN, PG8_SP2>(F.lds, g, S, E);
                if (quad) { const Frame F = launder(F0); pg8::SplitTailOrder S2; S2.S0.init(NROW, 2 * DFF, F.G, F.bx); S2.npair = DM / 128;
                  pg8::EpiSwigluQuad E2{FW(bf16, WS_U), DFF, 1 << 30, FW(float, WS_PT), (unsigned*)(F.a->ws + WS_CTL) + CW_TFLAG};
                  pg8::gemm_phase<pg8::EpiSwigluQuad, pg8::SplitTailOrder, PG8_ALIGN, PG8_SP2>(F.lds, g, S2, E2); }
                if (F.G == 256 && F.bx >= 44) cvt_moe_range(F0, CV0 + CV_NIN, CV0 + CV_NIN + CV_NFF, (F.bx - 44) * NWAVES + F.wave, 212 * NWAVES);
                SEAM(pb + 8);
            }
            if (PHM(10) && IN(pb + 9)) for (int rep_ = 0; rep_ < NREP(pb + 9); ++rep_) {
                const Frame F = launder(F0); pg8::Gemm g{FW(bf16, WS_U), FW(bf16, WS_WF2), SEQ, DM, DFF, DFF}; pg8::StaticOrder S; S.init(SEQ, DM, F.G, F.bx);
                const float* md = FW(float, WS_MODS);
                pg8::EpiResidB<false> E{nullptr, FW(bf16, WS_XB), md + 5 * 2048, DM};
                pg8::gemm_phase<pg8::EpiResidB<false>, pg8::StaticOrder, PG8_ALIGN, PG8_SP2>(F.lds, g, S, E);
                { const Frame F = launder(F0); pg8::Gemm g2{FW(bf16, WS_U), FW(bf16, WS_WF2), NROW, DM, 512, DFF}; pg8::SplitOrder S2{64, 8, 11, 512, F.G, F.bx};
                  pg8::EpiPartial E2{FW(float, WS_PC2), 512, DM};
                  pg8::gemm_phase<pg8::EpiPartial, pg8::SplitOrder, PG8_ALIGN, PG8_SP2>(F.lds, g2, S2, E2); }
                SEAM(pb + 9);
            }
        } else {
            if (PHM(11) && IN(pb + 8)) for (int rep_ = 0; rep_ < NREP(pb + 8); ++rep_) { ph_gather(F0); SEAM(pb + 8); }
            if (PHM(12) && IN(pb + 9)) for (int rep_ = 0; rep_ < NREP(pb + 9); ++rep_) {
                load_ptab(F0);
                const Frame F = launder(F0); pg8::Gemm g{FW(bf16, WS_H), FW(bf16, WS_WM13), PMAX * 256, 2 * DFF, DM / 2, DM / 2}; pg8::MoeOrderE S{(const LAS int*)(F.lds + SCR_OFF), 2 * DFF / 256, F.G, F.bx, (const int*)(F.a->ws + WS_SLOTTOK)};
                pg8::EpiSwiglu8 E{FW(unsigned char, WS_U), DFF, 2 * DFF / 256, (const LAS unsigned*)(F.lds + SCR_OFF) + 176, F8_SH, F8_SU};
                pg8::gemm_phase<pg8::EpiSwiglu8, pg8::MoeOrderE, PG8_ALIGN, PG8_SP2, true>(F.lds, g, S, E);
                SEAM(pb + 9);
            }
            if (PHM(13) && IN(pb + 10)) for (int rep_ = 0; rep_ < NREP(pb + 10); ++rep_) {
                load_ptab(F0);
                const Frame F = launder(F0); pg8::Gemm g{FW(bf16, WS_U), FW(bf16, WS_WM2), PMAX * 256, DM, DFF / 2, DFF / 2}; pg8::MoeOrder S{(const LAS int*)(F.lds + SCR_OFF), DM / 256, F.G, F.bx, 1};
                pg8::EpiStoreBf16S E{FW(bf16, WS_YP), DM, DM / 256, (const LAS unsigned*)(F.lds + SCR_OFF) + 176, F8_SU};
                pg8::gemm_phase<pg8::EpiStoreBf16S, pg8::MoeOrder, PG8_ALIGN, PG8_SP2, true>(F.lds, g, S, E);
                { const Frame F = launder(F0); pg8::MoeTailOrder S2{(const LAS int*)(F.lds + SCR_OFF), DM / 256, F.G, F.bx, DFF / 256}; const int sp = S2.splits();
                  if (sp) { pg8::Gemm g2{FW(bf16, WS_U), FW(bf16, WS_WM2), PMAX * 256, DM, DFF / 2, DFF / 2}; const int P = S2.tab[0];
                    pg8::EpiTailPartial E2{FW(float, WS_PT), P, DM / 256, ((8 * P) / F.G) * F.G, F.G / sp, (const LAS unsigned*)(F.lds + SCR_OFF) + 176, F8_SU};
                    pg8::gemm_phase<pg8::EpiTailPartial, pg8::MoeTailOrder, PG8_ALIGN, PG8_SP2, true>(F.lds, g2, S2, E2); } }
                SEAM(pb + 10);
            }
            if (PHM(14) && IN(pb + 11)) { ph_combine(F0); }
        }
    }
__global__ void __launch_bounds__(NTHR, 2) fwd_kernel(Args args) {
    extern __shared__ __attribute__((aligned(16))) unsigned char lds[];
    Frame F0;
    F0.lds = (LAS unsigned char*)lds;
    F0.tid = threadIdx.x; F0.lane = F0.tid & 63; F0.wave = __builtin_amdgcn_readfirstlane(F0.tid >> 6); F0.G = gridDim.x; F0.bx = blockIdx.x;
    F0.a = (const __attribute__((address_space(4))) Args*)__builtin_amdgcn_kernarg_segment_ptr();
    unsigned char* ws = args.ws;
    volatile LAS unsigned* MISC = (volatile LAS unsigned*)(F0.lds + MISC_OFF);
    for (int u = F0.tid; u < (LDS_BYTES - MISC_OFF) / 4; u += NTHR) ((LAS unsigned*)(F0.lds + MISC_OFF))[u] = 0u;
    __syncthreads();
    const int lo = args.ph_lo, hi = args.ph_hi;
    XcdBarrier bar; bar.bar = (unsigned*)(ws + WS_CTL) + CW_BAR; bar.x = 0; bar.st = MISC + 8;
    if (hi - lo > 1) bar = xcd_barrier_post((unsigned*)(ws + WS_CTL) + CW_BAR, MISC + 8);
    if (PHM(0) && IN(0)) for (int rep_ = 0; rep_ < NREP(0); ++rep_) { ph_ada(F0); SEAM(0); }
    if (PHM(1) && IN(1)) for (int rep_ = 0; rep_ < NREP(1); ++rep_) { ph_cvt(F0, F0.G == 256 ? CV0 : CVT_NMOE); SEAM(1); }
    layer_body<0>(F0, bar, lo, hi);
    layer_body<1>(F0, bar, lo, hi);
#undef IN
#undef SEAM
}

extern "C" void kernel_launch(void* const* d_in, const int* in_sizes, int n_in, void* d_out, int out_size, void* d_ws, size_t ws_size, hipStream_t stream) {
    static int grid = 0;
    if (grid == 0) {
        if (n_in != 23 || out_size != SEQ * DM || ws_size < WS_END) { fprintf(stderr, "kernel_launch: unexpected shapes (n_in %d, out %d, ws %zu); nothing launched\n", n_in, out_size, ws_size); grid = -1; return; }
        int dev = 0, cus = 0, per_cu = 0;
        if (hipGetDevice(&dev) != hipSuccess || hipDeviceGetAttribute(&cus, hipDeviceAttributeMultiprocessorCount, dev) != hipSuccess) { grid = -1; return; }
        if (hipFuncSetAttribute((const void*)fwd_kernel, hipFuncAttributeMaxDynamicSharedMemorySize, LDS_BYTES) != hipSuccess) { fprintf(stderr, "kernel_launch: hipFuncSetAttribute failed\n"); grid = -1; return; }
        if (hipOccupancyMaxActiveBlocksPerMultiprocessor(&per_cu, (const void*)fwd_kernel, NTHR, LDS_BYTES) != hipSuccess || per_cu < 1) { fprintf(stderr, "kernel_launch: occupancy query says %d blocks per CU\n", per_cu); }
        (void)hipGetLastError();
        grid = cus;
    }
    if (grid < 0) return;
    (void)hipMemsetAsync((char*)d_ws + WS_CTL, 0, CTL_ZERO_BYTES, stream);
    Args a{};
    for (int i = 0; i < 23; ++i) a.in[i] = (const float*)d_in[i];
    a.out = (float*)d_out; a.ws = (unsigned char*)d_ws;
#if MK_MULTI
    for (int p = 0; p < NPHASE; ++p) { if (p == 2 + 4 || p == 2 + 10 || p == 2 + 11 || p == 14 + 4) continue; a.ph_lo = p; a.ph_hi = p + 1; hipLaunchKernelGGL(fwd_kernel, dim3(grid), dim3(NTHR), LDS_BYTES, stream, a); }
#else
    a.ph_lo = 0; a.ph_hi = NPHASE;
    hipLaunchKernelGGL(fwd_kernel, dim3(grid), dim3(NTHR), LDS_BYTES, stream, a);
#endif
    (void)in_sizes;
}
```

```cpp
#include <hip/hip_runtime.h>
#include <cstdio>
#include <cstdint>
namespace pg8 {
#define PG8_LAS __attribute__((address_space(3)))
typedef unsigned short bf16_t;
typedef short bf16x8 __attribute__((ext_vector_type(8)));
typedef float f32x4 __attribute__((ext_vector_type(4)));
typedef unsigned u32x4 __attribute__((ext_vector_type(4)));
typedef int i32x4 __attribute__((ext_vector_type(4)));
typedef int i32x8 __attribute__((ext_vector_type(8)));
constexpr int BM = 256, BK = 64, HALF = 128, HTB = HALF * BK * 2  , STAGE_BYTES = 8 * HTB, NXCD = 8, WGM = 8;

__host__ __device__ __forceinline__ int lds_byte(int r, int c) { const int st = (r >> 4) * 2 + (c >> 5), rr = r & 15, cc = c & 31, ob = rr * 64 + cc * 2; return st * 1024 + (ob ^ (((ob >> 9) & 1) << 5)); }
__host__ __device__ __forceinline__ void stage_rc(int b, int& R, int& C) { const int st = b / 1024, sb = b % 1024, swz = sb ^ (((sb >> 9) & 1) << 5); R = (st >> 1) * 16 + swz / 64; C = (st & 1) * 32 + (swz % 64) / 2; }
__host__ __device__ __forceinline__ int perm32(int rho) { const int n = rho >> 4, i = rho & 15; return 8 * (i >> 2) + 4 * n + (i & 3); }

struct Unit { int pm, pn, ko, kt; };
struct Gemm { const bf16_t* A; const bf16_t* Bt; int M, N, K, ld; };

struct StaticOrder {
    static constexpr bool GATHER = false, VARK = false;
    int nM, nN, nwg, G, c;
    __host__ __device__ void init(int M, int N, int G_, int c_) { nM = M / BM; nN = N / BM; nwg = nM * nN; G = G_; c = c_; }
    __host__ __device__ bool next(int i, Unit& u) const {
        const long L = (long)i * G + c; if (L >= nwg) return false;
        int wgid = (int)L; { const int q = nwg / NXCD, r = nwg % NXCD, xcd = wgid % NXCD, off = wgid / NXCD; wgid = (xcd < r ? xcd * (q + 1) : r * (q + 1) + (xcd - r) * q) + off; }
        const int nig = WGM * nN, gid = wgid / nig, fm = gid * WGM, gsz = (nM - fm) < WGM ? (nM - fm) : WGM;
        u.pm = fm + ((wgid % nig) % gsz); u.pn = (wgid % nig) / gsz; u.ko = 0; return true;
    }
    __device__ __forceinline__ void a_ready(const Unit&) const {}
    __device__ __forceinline__ void done(const Unit&) const {}
};


__device__ __forceinline__ unsigned cvt_pk_bf16(float lo, float hi) { unsigned r; asm volatile("v_cvt_pk_bf16_f32 %0, %1, %2" : "=v"(r) : "v"(lo), "v"(hi)); return r; }
__device__ __forceinline__ float f8_scale(unsigned amax_bits) { const int ex = (int)((amax_bits >> 23) & 0xffu); if (ex == 0 || ex == 255) return 1.f;
    int se = 127 + 5 - (ex - 127); se = se < 1 ? 1 : (se > 254 ? 254 : se); return __uint_as_float((unsigned)se << 23); }
__device__ __forceinline__ unsigned pk4_fp8(float a, float b, float c, float d) {
    a = fminf(fmaxf(a, -448.f), 448.f); b = fminf(fmaxf(b, -448.f), 448.f); c = fminf(fmaxf(c, -448.f), 448.f); d = fminf(fmaxf(d, -448.f), 448.f);
    int w = __builtin_amdgcn_cvt_pk_fp8_f32(a, b, 0, false); w = __builtin_amdgcn_cvt_pk_fp8_f32(c, d, w, true); return (unsigned)w; }

__host__ __device__ __forceinline__ void moe_unit(long L, int P, int nN, int& pm, int& pn) {
    const int nwg = P * nN; int wgid = (int)L; { const int q = nwg / NXCD, r = nwg % NXCD, xcd = wgid % NXCD, off = wgid / NXCD; wgid = (xcd < r ? xcd * (q + 1) : r * (q + 1) + (xcd - r) * q) + off; }
    const int nig = WGM * nN, gid = wgid / nig, fm = gid * WGM, gsz = (P - fm) < WGM ? (P - fm) : WGM;
    pm = fm + ((wgid % nig) % gsz); pn = (wgid % nig) / gsz;
}
__host__ __device__ __forceinline__ int moe_index(int pm, int pn, int P, int nN) {
    const int nwg = P * nN, nig = WGM * nN, gid = pm / WGM, fm = gid * WGM, gsz = (P - fm) < WGM ? (P - fm) : WGM; const int wgid = gid * nig + pn * gsz + (pm - fm);
    const int q = nwg / NXCD, r = nwg % NXCD; int xcd, off; if (wgid < r * (q + 1)) { xcd = wgid / (q + 1); off = wgid % (q + 1); } else { const int t2 = wgid - r * (q + 1); xcd = r + t2 / q; off = t2 % q; }
    return off * NXCD + xcd;
}
struct MoeOrder {
    static constexpr bool GATHER = false, VARK = false;
    const PG8_LAS int* tab; int nN, G, c; int full_only;
    __device__ __forceinline__ bool next(int i, Unit& u) const {
        const int P = tab[0]; const long L = (long)i * G + c; const long U = (long)P * nN, lim = full_only ? (U / G) * G : U; if (L >= lim) return false;
        int pm, pn; moe_unit(L, P, nN, pm, pn); u.pm = pm; u.pn = tab[1 + pm] * nN + pn; u.ko = 0; return true;
    }
    __device__ __forceinline__ void a_ready(const Unit&) const {}
    __device__ __forceinline__ void done(const Unit&) const {}
};

struct MoeOrderE {
    static constexpr bool GATHER = true, VARK = false;
    const PG8_LAS int* tab; int nN, G, c; const int* slot_tok;
    __device__ __forceinline__ int arow(const Unit& u, int r) const { const int t = slot_tok[u.pm * BM + r]; return t < 0 ? 0 : t; }
    __device__ __forceinline__ bool next(int i, Unit& u) const {
        long L = (long)i * G + c; int e = 0, p0 = 0, np = 0;
        for (; e < 8; ++e) { p0 = tab[160 + e]; np = tab[161 + e] - p0; const long ue = (long)np * nN; if (L < ue) break; L -= ue; }
        if (e >= 8) return false;
        int pm, pn; moe_unit(L, np, nN, pm, pn); u.pm = p0 + pm; u.pn = e * nN + pn; u.ko = 0; return true;
    }
    __device__ __forceinline__ void a_ready(const Unit&) const {}
    __device__ __forceinline__ void done(const Unit&) const {}
};
__host__ __device__ __forceinline__ int tail_splits(int T, int G) { return T == 0 ? 0 : (G / T >= 6 ? 6 : (G / T >= 1 ? G / T : 1)); }
struct MoeTailOrder {
    static constexpr bool GATHER = false, VARK = true;
    const PG8_LAS int* tab; int nN, G, c, npair;
    __device__ __forceinline__ int splits() const { const int P = tab[0]; const long U = (long)P * nN; return tail_splits((int)(U - (U / G) * G), G); }
    __device__ __forceinline__ bool next(int i, Unit& u) const {
        const int P = tab[0]; const long U = (long)P * nN, full = (U / G) * G; const int T = (int)(U - full), s = tail_splits(T, G); const long j = (long)i * G + c; if (s == 0 || j >= (long)T * s) return false;
        const long L = full + j / s; const int ks = (int)(j % s); int pm, pn; moe_unit(L, P, nN, pm, pn); u.pm = pm; u.pn = tab[1 + pm] * nN + pn;
        const int base = npair / s, rem = npair % s, np = base + (ks < rem ? 1 : 0), p0 = ks * base + (ks < rem ? ks : rem);
        u.ko = p0 * 2 * BK; u.kt = (2 * np) | (ks << 8); return true;
    }
    __device__ __forceinline__ void a_ready(const Unit&) const {}
    __device__ __forceinline__ void done(const Unit&) const {}
};
struct SplitOrder {
    static constexpr bool GATHER = false, VARK = false;
    int pm0, nN, nS, ksplit, G, c;
    __device__ __forceinline__ bool next(int i, Unit& u) const { const long L = (long)i * G + c; if (L >= (long)nN * nS) return false; u.pm = pm0; u.pn = (int)(L % nN); u.ko = (int)(L / nN) * ksplit; return true; }
    __device__ __forceinline__ void a_ready(const Unit&) const {}
    __device__ __forceinline__ void done(const Unit&) const {}
};
struct EpiStoreBf16 {
    static constexpr bool PERM = true, AFTER_DRAIN = false;
    bf16_t* O; int ldc; int pn_mod;
    __device__ __forceinline__ void operator()(const f32x4 (&acc)[2][2][4][2], const Unit& u, int wr, int wc, int fr, int fq) const {
        const int row0 = u.pm * BM + wr * 64 + fr; const int col0 = (u.pn % pn_mod) * BM + wc * 32 + 8 * fq;
#pragma unroll
        for (int ai = 0; ai < 2; ++ai)
#pragma unroll
            for (int m = 0; m < 4; ++m) { bf16_t* rowp = O + (size_t)(row0 + ai * HALF + m * 16) * ldc + col0;
#pragma unroll
                for (int bj = 0; bj < 2; ++bj) { const f32x4 v0 = acc[ai][bj][m][0], v1 = acc[ai][bj][m][1];
                    u32x4 w; w.x = cvt_pk_bf16(v0[0], v0[1]); w.y = cvt_pk_bf16(v0[2], v0[3]); w.z = cvt_pk_bf16(v1[0], v1[1]); w.w = cvt_pk_bf16(v1[2], v1[3]);
                    *(u32x4*)(rowp + bj * HALF) = w; } }
    }
};
struct EpiSwiglu {
    static constexpr bool PERM = true, AFTER_DRAIN = false;
    bf16_t* O; int ldc; int pn_mod;
    __device__ __forceinline__ void operator()(const f32x4 (&acc)[2][2][4][2], const Unit& u, int wr, int wc, int fr, int fq) const {
        const int row0 = u.pm * BM + wr * 64 + fr; const int col0 = (u.pn % pn_mod) * HALF + wc * 32 + 8 * fq;
#pragma unroll
        for (int ai = 0; ai < 2; ++ai)
#pragma unroll
            for (int m = 0; m < 4; ++m) { bf16_t* rowp = O + (size_t)(row0 + ai * HALF + m * 16) * ldc + col0;
                float r[8];
#pragma unroll
                for (int n = 0; n < 2; ++n)
#pragma unroll
                    for (int i = 0; i < 4; ++i) { const float a = acc[ai][0][m][n][i], b = acc[ai][1][m][n][i];
                        const float sg = __builtin_amdgcn_rcpf(1.0f + __builtin_amdgcn_exp2f(-1.44269504089f * a)); r[n * 4 + i] = a * sg * b; }
                u32x4 w; w.x = cvt_pk_bf16(r[0], r[1]); w.y = cvt_pk_bf16(r[2], r[3]); w.z = cvt_pk_bf16(r[4], r[5]); w.w = cvt_pk_bf16(r[6], r[7]);
                *(u32x4*)rowp = w; }
    }
};
struct EpiSwiglu8 {
    static constexpr bool PERM = true, AFTER_DRAIN = false;
    unsigned char* O; int ldc; int pn_mod; const PG8_LAS unsigned* amax; float sa, so;
    __device__ __forceinline__ void operator()(const f32x4 (&acc)[2][2][4][2], const Unit& u, int wr, int wc, int fr, int fq) const {
        const int row0 = u.pm * BM + wr * 64 + fr; const int col0 = (u.pn % pn_mod) * HALF + wc * 32 + 8 * fq; const int ex = u.pn / pn_mod;
        const float i1 = 1.f / (sa * f8_scale(amax[3 * ex])), i3 = so / (sa * f8_scale(amax[3 * ex + 1]));
#pragma unroll
        for (int ai = 0; ai < 2; ++ai)
#pragma unroll
            for (int m = 0; m < 4; ++m) { unsigned char* rowp = O + (size_t)(row0 + ai * HALF + m * 16) * ldc + col0;
                float r[8];
#pragma unroll
                for (int n = 0; n < 2; ++n)
#pragma unroll
                    for (int i = 0; i < 4; ++i) { const float a = acc[ai][0][m][n][i] * i1, b = acc[ai][1][m][n][i] * i3;
                        const float sg = __builtin_amdgcn_rcpf(1.0f + __builtin_amdgcn_exp2f(-1.44269504089f * a)); r[n * 4 + i] = a * sg * b; }
                uint2 w; w.x = pk4_fp8(r[0], r[1], r[2], r[3]); w.y = pk4_fp8(r[4], r[5], r[6], r[7]);
                *(uint2*)rowp = w; }
    }
};
struct EpiStoreBf16S {
    static constexpr bool PERM = true, AFTER_DRAIN = false;
    bf16_t* O; int ldc; int pn_mod; const PG8_LAS unsigned* amax; float sa;
    __device__ __forceinline__ void operator()(const f32x4 (&acc)[2][2][4][2], const Unit& u, int wr, int wc, int fr, int fq) const {
        const int row0 = u.pm * BM + wr * 64 + fr; const int col0 = (u.pn % pn_mod) * BM + wc * 32 + 8 * fq; const float inv = 1.f / (sa * f8_scale(amax[3 * (u.pn / pn_mod) + 2]));
#pragma unroll
        for (int ai = 0; ai < 2; ++ai)
#pragma unroll
            for (int m = 0; m < 4; ++m) { bf16_t* rowp = O + (size_t)(row0 + ai * HALF + m * 16) * ldc + col0;
#pragma unroll
                for (int bj = 0; bj < 2; ++bj) { const f32x4 v0 = acc[ai][bj][m][0] * inv, v1 = acc[ai][bj][m][1] * inv;
                    u32x4 w; w.x = cvt_pk_bf16(v0[0], v0[1]); w.y = cvt_pk_bf16(v0[2], v0[3]); w.z = cvt_pk_bf16(v1[0], v1[1]); w.w = cvt_pk_bf16(v1[2], v1[3]);
                    *(u32x4*)(rowp + bj * HALF) = w; } }
    }
};
struct EpiResid {
    static constexpr bool PERM = false, AFTER_DRAIN = false;
    const float* res0; float* out0; const float* gate0; int ldc;
    __device__ __forceinline__ void operator()(const f32x4 (&acc)[2][2][4][2], const Unit& u, int wr, int wc, int fr, int fq) const {
        const int row0 = u.pm * BM + wr * 64 + fr, col0 = u.pn * BM + wc * 32 + 4 * fq;
        f32x4 gv[2][2];
#pragma unroll
        for (int bj = 0; bj < 2; ++bj)
#pragma unroll
            for (int n = 0; n < 2; ++n) gv[bj][n] = *(const f32x4*)(gate0 + col0 + bj * HALF + n * 16);
#pragma unroll
        for (int ai = 0; ai < 2; ++ai) {
            f32x4 r[4][2][2];
#pragma unroll
            for (int m = 0; m < 4; ++m) { const size_t off = (size_t)(row0 + ai * HALF + m * 16) * ldc + col0;
#pragma unroll
                for (int bj = 0; bj < 2; ++bj)
#pragma unroll
                    for (int n = 0; n < 2; ++n) r[m][bj][n] = *(const f32x4*)(res0 + off + bj * HALF + n * 16); }
#pragma unroll
            for (int m = 0; m < 4; ++m) { const size_t off = (size_t)(row0 + ai * HALF + m * 16) * ldc + col0;
#pragma unroll
                for (int bj = 0; bj < 2; ++bj)
#pragma unroll
                    for (int n = 0; n < 2; ++n) *(f32x4*)(out0 + off + bj * HALF + n * 16) = r[m][bj][n] + gv[bj][n] * acc[ai][bj][m][n]; }
        }
    }
};

struct EpiPartial {
    static constexpr bool PERM = false, AFTER_DRAIN = false;
    float* P; int ksplit; int ldc;
    __device__ __forceinline__ void operator()(const f32x4 (&acc)[2][2][4][2], const Unit& u, int wr, int wc, int fr, int fq) const {
        const int row0 = wr * 64 + fr, col0 = u.pn * BM + wc * 32 + 4 * fq; float* base = P + (size_t)(u.ko / ksplit) * BM * ldc;
#pragma unroll
        for (int ai = 0; ai < 2; ++ai)
#pragma unroll
            for (int m = 0; m < 4; ++m) { float* rp = base + (size_t)(row0 + ai * HALF + m * 16) * ldc + col0;
#pragma unroll
                for (int bj = 0; bj < 2; ++bj)
#pragma unroll
                    for (int n = 0; n < 2; ++n) *(f32x4*)(rp + bj * HALF + n * 16) = acc[ai][bj][m][n]; }
    }
};
template <bool RES32> struct EpiResidB {
    static constexpr bool PERM = true, AFTER_DRAIN = false;
    const float* res32; bf16_t* xb; const float* gate; int ldc;
    __device__ __forceinline__ void operator()(const f32x4 (&acc)[2][2][4][2], const Unit& u, int wr, int wc, int fr, int fq) const {
        const int row0 = u.pm * BM + wr * 64 + fr; const int col0 = u.pn * BM + wc * 32 + 8 * fq;
        f32x4 gv[2][2];
#pragma unroll
        for (int bj = 0; bj < 2; ++bj)
#pragma unroll
            for (int n = 0; n < 2; ++n) gv[bj][n] = *(const f32x4*)(gate + col0 + bj * HALF + 4 * n);
#pragma unroll
        for (int ai = 0; ai < 2; ++ai) {
            f32x4 r[4][2][2];
#pragma unroll
            for (int m = 0; m < 4; ++m) { const size_t off = (size_t)(row0 + ai * HALF + m * 16) * ldc + col0;
#pragma unroll
                for (int bj = 0; bj < 2; ++bj) {
                    if constexpr (RES32) { r[m][bj][0] = *(const f32x4*)(res32 + off + bj * HALF); r[m][bj][1] = *(const f32x4*)(res32 + off + bj * HALF + 4); }
                    else { const u32x4 w = *(const u32x4*)(xb + off + bj * HALF);
                        r[m][bj][0] = (f32x4){__uint_as_float(w.x << 16), __uint_as_float(w.x & 0xffff0000u), __uint_as_float(w.y << 16), __uint_as_float(w.y & 0xffff0000u)};
                        r[m][bj][1] = (f32x4){__uint_as_float(w.z << 16), __uint_as_float(w.z & 0xffff0000u), __uint_as_float(w.w << 16), __uint_as_float(w.w & 0xffff0000u)}; } } }
#pragma unroll
            for (int m = 0; m < 4; ++m) { const size_t off = (size_t)(row0 + ai * HALF + m * 16) * ldc + col0;
#pragma unroll
                for (int bj = 0; bj < 2; ++bj) { const f32x4 v0 = r[m][bj][0] + gv[bj][0] * acc[ai][bj][m][0], v1 = r[m][bj][1] + gv[bj][1] * acc[ai][bj][m][1];
                    u32x4 w; w.x = cvt_pk_bf16(v0[0], v0[1]); w.y = cvt_pk_bf16(v0[2], v0[3]); w.z = cvt_pk_bf16(v1[0], v1[1]); w.w = cvt_pk_bf16(v1[2], v1[3]);
                    *(u32x4*)(xb + off + bj * HALF) = w; } }
        }
    }
};
struct EpiTailPartial {
    static constexpr bool PERM = false, AFTER_DRAIN = false;
    float* PT; int P, nN, full, tcap; const PG8_LAS unsigned* amax; float sa;
    __device__ __forceinline__ void operator()(const f32x4 (&acc)[2][2][4][2], const Unit& u, int wr, int wc, int fr, int fq) const {
        const int idx = moe_index(u.pm, u.pn % nN, P, nN) - full, s = u.kt >> 8; const float inv = 1.f / (sa * f8_scale(amax[3 * (u.pn / nN) + 2]));
        float* base = PT + (size_t)(s * tcap + idx) * (BM * BM) + (size_t)(wr * 64 + fr) * BM + wc * 32 + 4 * fq;
#pragma unroll
        for (int ai = 0; ai < 2; ++ai)
#pragma unroll
            for (int m = 0; m < 4; ++m) { float* rp = base + (size_t)(ai * HALF + m * 16) * BM;
#pragma unroll
                for (int bj = 0; bj < 2; ++bj)
#pragma unroll
                    for (int n = 0; n < 2; ++n) *(f32x4*)(rp + bj * HALF + n * 16) = acc[ai][bj][m][n] * inv; }
    }
};
template <class Epi, class Sched, bool ALIGN_EPI = false, bool SP2 = false, bool FP8 = false>
__device__ __forceinline__ void gemm_phase(PG8_LAS unsigned char* lds, const Gemm g, const Sched& S, const Epi& E) {
    int tid_ = threadIdx.x; asm volatile("" : "+v"(tid_)); const int tid = tid_, wid = __builtin_amdgcn_readfirstlane(tid >> 6), lane = tid & 63, wr = wid >> 2, wc = wid & 3, fr = lane & 15, fq = lane >> 4;
    const int K = g.ld; int nt = g.K / BK;
    unsigned voffA[2], voffB[2];
#pragma unroll
    for (int i = 0; i < 2; ++i) { int R, C; stage_rc(tid * 16 + i * 8192, R, C); const int Rb = Epi::PERM ? ((R & ~31) + perm32(R & 31)) : R;
        voffA[i] = (unsigned)(R * K + C) * 2u; voffB[i] = (unsigned)(Rb * K + C) * 2u; }
    const size_t kstep = (size_t)(BK * 2);
    const size_t hstep = (size_t)HALF * K * 2;
    const size_t tstep = 2 * hstep;
    const unsigned ldsw = (unsigned)wid * 1024u;
    const int aoff = lds_byte(wr * 64 + fr, fq * 8), boff = lds_byte(wc * 32 + fr, fq * 8);
#define PG8_SA(b, h) (((b) * 2 + (h)) * HTB)
#define PG8_SB(b, h) ((4 + (b) * 2 + (h)) * HTB)
#define PG8_STAGE(bufoff, gbase, voff) do { _Pragma("unroll") for (int _i = 0; _i < 2; ++_i) \
        __builtin_amdgcn_global_load_lds((const unsigned*)((const char*)(gbase) + (voff)[_i]), (PG8_LAS unsigned*)(lds + (bufoff) + ldsw + _i * 8192), 16, 0, 0); } while (0)
#define PG8_LD8(p) __builtin_shufflevector(*(const PG8_LAS i32x4*)(p), *(const PG8_LAS i32x4*)((p) + 1024), 0, 1, 2, 3, 4, 5, 6, 7)
#define PG8_LDA(dst, b, h) do { if constexpr (FP8) { _Pragma("unroll") for (int m = 0; m < 4; ++m) dst##8[m] = PG8_LD8(lds + PG8_SA(b, h) + aoff + m * 2048); } else { \
        _Pragma("unroll") for (int m = 0; m < 4; ++m) _Pragma("unroll") for (int k = 0; k < 2; ++k) dst[m][k] = *(const PG8_LAS bf16x8*)(lds + PG8_SA(b, h) + aoff + m * 2048 + k * 1024); } } while (0)
#define PG8_LDB(dst, b, h) do { if constexpr (FP8) { _Pragma("unroll") for (int n = 0; n < 2; ++n) dst##8[n] = PG8_LD8(lds + PG8_SB(b, h) + boff + n * 2048); } else { \
        _Pragma("unroll") for (int n = 0; n < 2; ++n) _Pragma("unroll") for (int k = 0; k < 2; ++k) dst[n][k] = *(const PG8_LAS bf16x8*)(lds + PG8_SB(b, h) + boff + n * 2048 + k * 1024); } } while (0)
#define PG8_CAT8(x, y) __builtin_shufflevector(__builtin_bit_cast(i32x4, x), __builtin_bit_cast(i32x4, y), 0, 1, 2, 3, 4, 5, 6, 7)
#define PG8_MMA(ai, bj, At, Bt) do { __builtin_amdgcn_s_setprio(1); if constexpr (FP8) { _Pragma("unroll") for (int m = 0; m < 4; ++m) _Pragma("unroll") for (int n = 0; n < 2; ++n) \
        asm volatile("v_mfma_f32_16x16x128_f8f6f4 %0, %1, %2, %0" : "+v"(acc[ai][bj][m][n]) : "v"(Bt##8[n]), "v"(At##8[m])); } else { \
        _Pragma("unroll") for (int m = 0; m < 4; ++m) _Pragma("unroll") for (int n = 0; n < 2; ++n) _Pragma("unroll") for (int k = 0; k < 2; ++k) \
        acc[ai][bj][m][n] = __builtin_amdgcn_mfma_f32_16x16x32_bf16(Bt[n][k], At[m][k], acc[ai][bj][m][n], 0, 0, 0); } __builtin_amdgcn_s_setprio(0); } while (0)
#define PG8_WAIT_V(n) asm volatile("s_waitcnt vmcnt(" #n ")" ::: "memory")
#define PG8_WAIT_L(n) asm volatile("s_waitcnt lgkmcnt(" #n ")" ::: "memory")
#define PG8_BAR __builtin_amdgcn_s_barrier()
#define PG8_SCHED __builtin_amdgcn_sched_barrier(0)
    Unit cur, nxt; int ui = 0;
    if (!S.next(0, cur)) return;
    if constexpr (Sched::VARK) nt = cur.kt & 255;
    unsigned va[2][2], vn[2][2]; int gR[2], gC[2];
    if constexpr (Sched::GATHER) {
#pragma unroll
        for (int i = 0; i < 2; ++i) { stage_rc(tid * 16 + i * 8192, gR[i], gC[i]); }
#pragma unroll
        for (int h = 0; h < 2; ++h)
#pragma unroll
            for (int i = 0; i < 2; ++i) { va[h][i] = (unsigned)(S.arow(cur, 128 * h + gR[i]) * K + gC[i]) * 2u; vn[h][i] = va[h][i]; }
    }
#define PG8_STAGEA(bufoff, gbase, h, nx) do { if constexpr (Sched::GATHER) { _Pragma("unroll") for (int _i = 0; _i < 2; ++_i) { const unsigned _vo = (nx) ? vn[h][_i] : va[h][_i]; \
        __builtin_amdgcn_global_load_lds((const unsigned*)((const char*)(gbase) + _vo), (PG8_LAS unsigned*)(lds + (bufoff) + ldsw + _i * 8192), 16, 0, 0); } } \
        else { PG8_STAGE(bufoff, (gbase) + ((h) ? hstep : 0), voffA); } } while (0)
    f32x4 acc[2][2][4][2];
#pragma unroll
    for (int a = 0; a < 2; ++a)
#pragma unroll
        for (int b = 0; b < 2; ++b)
#pragma unroll
            for (int m = 0; m < 4; ++m)
#pragma unroll
                for (int n = 0; n < 2; ++n) acc[a][b][m][n] = (f32x4){0.f, 0.f, 0.f, 0.f};
    bf16x8 At[4][2], B0[2][2], B1[2][2]; i32x8 At8[4], B08[2], B18[2];
    const char* cA = (const char*)g.A + (Sched::GATHER ? (size_t)0 : (size_t)cur.pm * tstep) + (size_t)cur.ko * 2; const char* cB = (const char*)g.Bt + (size_t)cur.pn * tstep + (size_t)cur.ko * 2;
    S.a_ready(cur);
    if constexpr (SP2) {
        PG8_STAGE(PG8_SB(0, 0), cB, voffB); PG8_STAGE(PG8_SB(0, 1), cB + hstep, voffB); PG8_STAGEA(PG8_SA(0, 0), cA, 0, false); PG8_STAGEA(PG8_SA(0, 1), cA, 1, false);
        if (wr == 1) PG8_BAR;
        PG8_WAIT_V(2); PG8_BAR;
        PG8_STAGE(PG8_SB(1, 0), cB + kstep, voffB); PG8_STAGEA(PG8_SA(1, 0), cA + kstep, 0, false); PG8_STAGE(PG8_SB(1, 1), cB + hstep + kstep, voffB);
        PG8_WAIT_V(6); PG8_BAR;
    } else {
        PG8_STAGE(PG8_SB(0, 0), cB, voffB); PG8_STAGEA(PG8_SA(0, 0), cA, 0, false); PG8_STAGE(PG8_SB(0, 1), cB + hstep, voffB); PG8_STAGEA(PG8_SA(0, 1), cA, 1, false);
        if (wr == 1) PG8_BAR;
        PG8_WAIT_V(4); PG8_BAR;
        PG8_STAGE(PG8_SB(1, 0), cB + kstep, voffB); PG8_STAGEA(PG8_SA(1, 0), cA + kstep, 0, false); PG8_STAGE(PG8_SB(1, 1), cB + hstep + kstep, voffB);
        PG8_WAIT_V(6); PG8_BAR;
    }
    for (;;) {
        const bool has_next = S.next(ui + 1, nxt);
        if constexpr (Sched::GATHER) { if (has_next) {
#pragma unroll
            for (int h = 0; h < 2; ++h)
#pragma unroll
                for (int i = 0; i < 2; ++i) vn[h][i] = (unsigned)(S.arow(nxt, 128 * h + gR[i]) * K + gC[i]) * 2u; }
            else {
#pragma unroll
                for (int h = 0; h < 2; ++h)
#pragma unroll
                    for (int i = 0; i < 2; ++i) vn[h][i] = va[h][i]; } }
        const char* nA = has_next ? (const char*)g.A + (Sched::GATHER ? (size_t)0 : (size_t)nxt.pm * tstep) + (size_t)nxt.ko * 2 : cA; const char* nB = has_next ? (const char*)g.Bt + (size_t)nxt.pn * tstep + (size_t)nxt.ko * 2 : cB;
        for (int t = 0; t < nt; t += 2) {
            const bool last = (t == nt - 2);
            const char* a1 = cA + (size_t)(t + 1) * kstep;
            const char* a2 = last ? nA : cA + (size_t)(t + 2) * kstep; const char* b2 = last ? nB : cB + (size_t)(t + 2) * kstep;
            const char* a3 = a2 + kstep; const char* b3 = b2 + kstep;
            if (last && has_next) S.a_ready(nxt);
            if constexpr (SP2) {
            PG8_LDB(B0, 0, 0); PG8_LDB(B1, 0, 1); PG8_SCHED; PG8_LDA(At, 0, 0); PG8_STAGEA(PG8_SA(1, 1), a1, 1, false);
            PG8_WAIT_V(8); PG8_WAIT_L(0); PG8_BAR; PG8_MMA(0, 0, At, B0); PG8_MMA(0, 1, At, B1); PG8_BAR; PG8_SCHED;
            PG8_LDA(At, 0, 1); PG8_STAGE(PG8_SB(0, 0), b2, voffB); PG8_STAGE(PG8_SB(0, 1), b2 + hstep, voffB); PG8_STAGEA(PG8_SA(0, 0), a2, 0, last);
            PG8_WAIT_V(8); PG8_WAIT_L(0); PG8_BAR; PG8_MMA(1, 0, At, B0); PG8_MMA(1, 1, At, B1); PG8_BAR; PG8_SCHED;
            PG8_LDB(B0, 1, 0); PG8_LDB(B1, 1, 1); PG8_SCHED; PG8_LDA(At, 1, 0); PG8_STAGEA(PG8_SA(0, 1), a2, 1, last);
            PG8_WAIT_V(8); PG8_WAIT_L(0); PG8_BAR; PG8_MMA(0, 0, At, B0); PG8_MMA(0, 1, At, B1); PG8_BAR; PG8_SCHED;
            PG8_LDA(At, 1, 1); PG8_STAGE(PG8_SB(1, 0), b3, voffB); PG8_STAGE(PG8_SB(1, 1), b3 + hstep, voffB); PG8_STAGEA(PG8_SA(1, 0), a3, 0, last);
            PG8_WAIT_V(8); PG8_WAIT_L(0); PG8_BAR; PG8_MMA(1, 0, At, B0); PG8_MMA(1, 1, At, B1); PG8_BAR; PG8_SCHED;
            } else {
            PG8_LDB(B0, 0, 0); PG8_SCHED; PG8_LDA(At, 0, 0); PG8_STAGEA(PG8_SA(1, 1), a1, 1, false);
            PG8_WAIT_L(8); PG8_BAR; PG8_WAIT_L(0); PG8_MMA(0, 0, At, B0); PG8_BAR; PG8_SCHED;
            PG8_LDB(B1, 0, 1); PG8_STAGE(PG8_SB(0, 0), b2, voffB);
            PG8_BAR; PG8_WAIT_L(0); PG8_MMA(0, 1, At, B1); PG8_BAR;
            PG8_LDA(At, 0, 1); PG8_STAGEA(PG8_SA(0, 0), a2, 0, last);
            PG8_BAR; PG8_WAIT_L(0); PG8_MMA(1, 0, At, B0); PG8_BAR; PG8_SCHED;
            PG8_STAGE(PG8_SB(0, 1), b2 + hstep, voffB);
            PG8_WAIT_V(6); PG8_BAR; PG8_MMA(1, 1, At, B1); PG8_BAR;
            PG8_LDB(B0, 1, 0); PG8_SCHED; PG8_LDA(At, 1, 0); PG8_STAGEA(PG8_SA(0, 1), a2, 1, last);
            PG8_WAIT_L(8); PG8_BAR; PG8_WAIT_L(0); PG8_MMA(0, 0, At, B0); PG8_BAR; PG8_SCHED;
            PG8_LDB(B1, 1, 1); PG8_STAGE(PG8_SB(1, 0), b3, voffB);
            PG8_BAR; PG8_WAIT_L(0); PG8_MMA(0, 1, At, B1); PG8_BAR;
            PG8_LDA(At, 1, 1); PG8_STAGEA(PG8_SA(1, 0), a3, 0, last);
            PG8_BAR; PG8_WAIT_L(0); PG8_MMA(1, 0, At, B0); PG8_BAR; PG8_SCHED;
            PG8_STAGE(PG8_SB(1, 1), b3 + hstep, voffB);
            PG8_WAIT_V(6); PG8_BAR; PG8_MMA(1, 1, At, B1); PG8_BAR;
            }
        }
        if constexpr (ALIGN_EPI) { if (wr == 0) PG8_BAR; }
        if constexpr (FP8) asm volatile("s_nop 15\n\ts_nop 15\n\ts_nop 15" ::: "memory");
        if constexpr (!Epi::AFTER_DRAIN) { E(acc, cur, wr, wc, fr, fq); S.done(cur); }
        if (!has_next) break;
#pragma unroll
        for (int a = 0; a < 2; ++a)
#pragma unroll
            for (int b = 0; b < 2; ++b)
#pragma unroll
                for (int m = 0; m < 4; ++m)
#pragma unroll
                    for (int n = 0; n < 2; ++n) acc[a][b][m][n] = (f32x4){0.f, 0.f, 0.f, 0.f};
        cur = nxt; cA = nA; cB = nB; ++ui;
        if constexpr (Sched::VARK) nt = cur.kt & 255;
        if constexpr (Sched::GATHER) {
#pragma unroll
            for (int h = 0; h < 2; ++h)
#pragma unroll
                for (int i = 0; i < 2; ++i) va[h][i] = vn[h][i]; }
        if constexpr (ALIGN_EPI) { if (wr == 1) PG8_BAR; }
    }
    PG8_WAIT_V(0);
    if constexpr (!ALIGN_EPI) { if (wr == 0) PG8_BAR; }
    PG8_BAR;
    if constexpr (Epi::AFTER_DRAIN) { E.fused(acc, cur, wr, wc, fr, fq, lds, wid, lane); S.done(cur); }
#undef PG8_SA
#undef PG8_SB
#undef PG8_STAGE
#undef PG8_STAGEA
#undef PG8_LDA
#undef PG8_LD8
#undef PG8_LDB
#undef PG8_MMA
#undef PG8_CAT8
#undef PG8_WAIT_V
#undef PG8_WAIT_L
#undef PG8_BAR
#undef PG8_SCHED
}
}

constexpr int DM = 2048, SEQ = 16384, CTXN = 256, NROW = SEQ + CTXN, HD = 128, INC = 5632, DFF = 5632, NEXP = 8;
constexpr int C_QA = 0, C_KA = 1024, C_VA = 1280, C_QR = 1536, C_KR = 2560, C_VR = 3584, C_GR = 4608;
constexpr int NBLK = NROW / 128;
constexpr int PMAX = 136;
constexpr float EPS = 1e-6f;
constexpr int NWAVES = 8, NTHR = 512;

constexpr size_t MiB = 1u << 20;
constexpr size_t WS_CTL = 0, CTL_ZERO_BYTES = 1 * MiB;
constexpr size_t WS_MODS = 1 * MiB;
constexpr size_t WS_PART = 2 * MiB;
constexpr size_t WS_ROPE = 5 * MiB;
constexpr size_t WS_SEL = 6 * MiB;
constexpr size_t WS_SLOTTOK = 6 * MiB + 512 * 1024;
constexpr size_t WS_SLOTG = 6 * MiB + 768 * 1024;
constexpr size_t WS_TOKSLOT = 7 * MiB;
constexpr size_t WS_RBCNT = 8 * MiB;
constexpr size_t WS_PTAB = 8 * MiB + 65536;
constexpr size_t WS_XCTX = 10 * MiB;
constexpr size_t WS_WIN = 16 * MiB;
constexpr size_t WS_WOUT = 60 * MiB;
constexpr size_t WS_WF13 = 76 * MiB;
constexpr size_t WS_WF2 = 120 * MiB;
constexpr size_t WS_WM13 = 142 * MiB;
constexpr size_t WS_WM2 = 494 * MiB;
constexpr size_t WS_H = 670 * MiB;
constexpr size_t WS_RA = 735 * MiB;
constexpr size_t WS_PROJ = WS_RA, WS_KV = WS_RA + 179 * MiB, WS_SPREV = WS_RA + 309 * MiB, WS_U = WS_RA;
constexpr size_t WS_RB = 1109 * MiB;
constexpr size_t WS_MIX = WS_RB, WS_VAT = WS_RB + 65 * MiB, WS_VRT = WS_RB + 107 * MiB, WS_H2G = WS_RB;
constexpr size_t WS_YP = 1249 * MiB;
constexpr size_t WS_PC1 = 1385 * MiB;
constexpr size_t WS_PC2 = 1401 * MiB;
constexpr size_t WS_XB = 1423 * MiB;
constexpr size_t WS_PT = 1487 * MiB;
constexpr size_t WS_END = 1551 * MiB;
static_assert((size_t)NROW * INC * 2 <= 179 * MiB && (size_t)NBLK * 8 * 2 * 128 * 128 * 4 <= 130 * MiB && (size_t)NBLK * 8 * 2 * 128 * 128 * 2 <= 65 * MiB && (size_t)PMAX * 256 * DFF * 2 <= 374 * MiB, "region A");
static_assert((size_t)NROW * DM * 2 <= 65 * MiB && (size_t)NBLK * 2 * 128 * 128 * 2 <= 9 * MiB && (size_t)NBLK * 8 * 128 * 128 * 2 <= 33 * MiB && (size_t)PMAX * 256 * DM * 2 <= 140 * MiB, "region B");
constexpr int CW_AMAX = 16384;
constexpr float F8_SH = 2.f, F8_SU = 2.f;
constexpr int CW_BAR = 4096;

constexpr int SCR_OFF = 143360;
constexpr int MISC_OFF = 147456;
constexpr int LDS_BYTES = 151552;

#define GAS __attribute__((address_space(1)))
#define LAS __attribute__((address_space(3)))
#define DI __device__ __forceinline__
typedef unsigned short bf16;
typedef unsigned v4u __attribute__((ext_vector_type(4)));
typedef unsigned v2u __attribute__((ext_vector_type(2)));
typedef float f32x4 __attribute__((ext_vector_type(4)));
typedef float f32x2 __attribute__((ext_vector_type(2)));
typedef short bf16x8 __attribute__((ext_vector_type(8)));
#define LDS_WAIT() asm volatile("s_waitcnt lgkmcnt(0)" ::: "memory")
#define VM_WAIT() asm volatile("s_waitcnt vmcnt(0)" ::: "memory")
#define MFMA16(a, b, c) __builtin_amdgcn_mfma_f32_16x16x32_bf16((a), (b), (c), 0, 0, 0)
DI unsigned pk2(float lo, float hi) { return pg8::cvt_pk_bf16(lo, hi); }
DI unsigned pk2_safe(float lo, float hi) { const unsigned a = __float_as_uint(lo), b = __float_as_uint(hi); return ((a + 0x7fffu + ((a >> 16) & 1u)) >> 16) | ((b + 0x7fffu + ((b >> 16) & 1u)) & 0xffff0000u); }
DI float bflo(unsigned w) { return __uint_as_float(w << 16); }
DI float bfhi(unsigned w) { return __uint_as_float(w & 0xffff0000u); }
DI float ex2(float x) { return __builtin_amdgcn_exp2f(x); }
DI float wave_sum(float v) {
#pragma unroll
    for (int o = 1; o < 64; o <<= 1) v += __shfl_xor(v, o);
    return v;
}

#define XB_TMO      128
#define XB_XCNT(j)  (256  + 64 * (j))
#define XB_XSUB(j)  (1280 + 64 * (j))
#define XB_XGEN(j)  (2304 + 64 * (j))
#define XB_TOP      3328
#define XB_TOPGEN   3392
#define XCD_BAR_WORDS 3456
#define XB_SPIN_CAP (1u << 18)

__device__ __forceinline__ unsigned xb_ld(unsigned* p)              { return __hip_atomic_load(p, __ATOMIC_RELAXED, __HIP_MEMORY_SCOPE_AGENT); }
__device__ __forceinline__ unsigned xb_add(unsigned* p, unsigned v) { return __hip_atomic_fetch_add(p, v, __ATOMIC_RELAXED, __HIP_MEMORY_SCOPE_AGENT); }
__device__ __forceinline__ unsigned xb_xcc_id() { return (unsigned)__builtin_amdgcn_s_getreg((3 << 11) | 20) & 0xFu; }
#define XB_SPIN(cond, bar) do { unsigned _sp = 0; while (cond) { __builtin_amdgcn_s_sleep(1); \
    if ((++_sp & 255u) == 0u) { if (xb_ld(&(bar)[XB_TMO])) break; if (_sp > XB_SPIN_CAP) { atomicAdd(&(bar)[XB_TMO], 1u); break; } } } } while (0)

struct XcdBarrier {
    unsigned* bar; unsigned x;
    volatile LAS unsigned* st;
};

__device__ __forceinline__ XcdBarrier xcd_barrier_post(unsigned* bar, volatile LAS unsigned* st) {
    XcdBarrier b; b.bar = bar; b.x = xb_xcc_id(); b.st = st;
    if (threadIdx.x == 0) (void)xb_add(&bar[XB_XCNT(b.x)], 1u);
    return b;
}
__device__ __forceinline__ void xcd_barrier_complete(unsigned* bar, unsigned x, unsigned& nloc, unsigned& nx) {
    const unsigned G = gridDim.x * gridDim.y * gridDim.z;
    unsigned sum, cnt, mine, sp = 0u;
    for (;;) {
        sum = 0u; cnt = 0u; mine = 0u;
#pragma unroll
        for (unsigned j = 0; j < 16; ++j) { const unsigned c = xb_ld(&bar[XB_XCNT(j)]); sum += c; cnt += (c > 0u) ? 1u : 0u; mine = (j == x) ? c : mine; }
        if (sum == G) break;
        __builtin_amdgcn_s_sleep(1);
        if ((++sp & 255u) == 0u) { if (xb_ld(&bar[XB_TMO])) break; if (sp > XB_SPIN_CAP) { atomicAdd(&bar[XB_TMO], 1u); break; } }
    }
    nloc = mine > 0u ? mine : 1u; nx = cnt > 0u ? cnt : 1u;
}

__device__ __forceinline__ void xcd_barrier(const XcdBarrier& b) {
    asm volatile("s_waitcnt vmcnt(0)" ::: "memory");
    __syncthreads();
    if (threadIdx.x == 0) {
        unsigned* bar = b.bar;
        __builtin_amdgcn_s_waitcnt(0);
        unsigned nloc = b.st[0], nx = b.st[1];
        if (nloc == 0u) { xcd_barrier_complete(bar, b.x, nloc, nx); b.st[0] = nloc; b.st[1] = nx; }
        const unsigned old = xb_add(&bar[XB_XSUB(b.x)], 1u);
        const unsigned gen = old / nloc;
        if (old + 1u == (gen + 1u) * nloc) {
            __builtin_amdgcn_fence(__ATOMIC_RELEASE, "agent");
            asm volatile("s_waitcnt vmcnt(0)" ::: "memory");
            const unsigned og = xb_add(&bar[XB_TOP], 1u);
            const unsigned tg = og / nx;
            if (og + 1u == (tg + 1u) * nx) xb_add(&bar[XB_TOPGEN], 1u);
            else XB_SPIN(xb_ld(&bar[XB_TOPGEN]) == tg, bar);
            __builtin_amdgcn_fence(__ATOMIC_ACQUIRE, "agent");
            xb_add(&bar[XB_XGEN(b.x)], 1u);
            asm volatile("s_waitcnt vmcnt(0)" ::: "memory");
        } else {
            XB_SPIN(xb_ld(&bar[XB_XGEN(b.x)]) == gen, bar);
            __builtin_amdgcn_fence(__ATOMIC_ACQUIRE, "agent");
            asm volatile("s_waitcnt vmcnt(0)" ::: "memory");
        }
    }
    __syncthreads();
}

struct Args { const float* in[23]; float* out; unsigned char* ws; int ph_lo, ph_hi; };
struct Frame {
    LAS unsigned char* lds;
    int tid, lane, wave, G, bx;
    const __attribute__((address_space(4))) Args* a;
};
#define FW(T, off) ((T*)(F.a->ws + (off)))
DI Frame launder(const Frame& F0) { Frame F = F0; asm volatile("" : "+v"(F.tid)); const __attribute__((address_space(4))) Args* a = F0.a; asm volatile("" : "+s"(a)); F.a = a; F.lane = F.tid & 63; F.wave = __builtin_amdgcn_readfirstlane(F.tid >> 6); return F; }

enum { I_X = 0, I_C, I_CTX, I_CCTX, I_ADAW, I_ADAB, I_N1G, I_N2G, I_WIN, I_QG, I_KG, I_SINK, I_DECAY, I_GNG, I_WOUT, I_F1, I_F3, I_F2, I_RW, I_RB, I_M1, I_M3, I_M2 };

DI void ph_ada(const Frame& F0) { const Frame F = launder(F0);
    LAS float* sc = (LAS float*)F.lds;
    for (int i = F.tid; i < 2048; i += NTHR) { const float a = F.a->in[I_C][i], b = F.a->in[I_CCTX][i]; sc[i] = a / (1.f + expf(-a)); sc[2048 + i] = b / (1.f + expf(-b)); }
    __syncthreads();
    const int gw = F.bx * NWAVES + F.wave, NGW = F.G * NWAVES;
    for (int it = gw; it < 1536; it += NGW) {
        const int l = it / 768, r = it % 768, ks = r / 48, cg = r % 48;
        const GAS float* W = (const GAS float*)F.a->in[I_ADAW] + (size_t)l * 2048 * 12288 + (size_t)(ks * 128) * 12288 + cg * 256 + F.lane * 4;
        f32x4 a0 = (f32x4){0.f, 0.f, 0.f, 0.f}, a1 = a0;
#pragma unroll 8
        for (int k = 0; k < 128; ++k) { const f32x4 w = __builtin_nontemporal_load((const GAS f32x4*)(W + (size_t)k * 12288)); const float s0 = sc[ks * 128 + k], s1 = sc[2048 + ks * 128 + k]; a0 += s0 * w; a1 += s1 * w; }
        float* P = FW(float, WS_PART) + ((size_t)(l * 16 + ks) * 2) * 12288 + cg * 256 + F.lane * 4;
        *(f32x4*)P = a0; *(f32x4*)(P + 12288) = a1;
    }
    unsigned* AMAX = (unsigned*)(F.a->ws + WS_CTL) + CW_AMAX;
    for (int it = NGW - 1 - gw; it < 8 * 608; it += NGW) { const int e = it / 608, r = it % 608; const int k = r < 128 ? 0 : (r < 256 ? 1 : 2), row = (r - (k == 0 ? 0 : (k == 1 ? 128 : 256))) * 16, N = k == 2 ? DM : DFF;
        const float* W = (k == 0 ? F.a->in[I_M1] : (k == 1 ? F.a->in[I_M3] : F.a->in[I_M2])) + (size_t)e * DM * DFF;
        const GAS f32x4* p = (const GAS f32x4*)(W + (size_t)row * N) + F.lane; float m = 0.f;
        if (k == 2) { f32x4 v[8];
#pragma unroll
            for (int j = 0; j < 8; ++j) v[j] = p[64 * j];
#pragma unroll
            for (int j = 0; j < 8; ++j) m = fmaxf(m, fmaxf(fmaxf(fabsf(v[j].x), fabsf(v[j].y)), fmaxf(fabsf(v[j].z), fabsf(v[j].w)))); }
        else { f32x4 v[22];
#pragma unroll
            for (int j = 0; j < 22; ++j) v[j] = p[64 * j];
#pragma unroll
            for (int j = 0; j < 22; ++j) m = fmaxf(m, fmaxf(fmaxf(fabsf(v[j].x), fabsf(v[j].y)), fmaxf(fabsf(v[j].z), fabsf(v[j].w)))); }
#pragma unroll
        for (int o = 1; o < 64; o <<= 1) m = fmaxf(m, __shfl_xor(m, o));
        if (F.lane == 0) __hip_atomic_fetch_max(AMAX + 3 * e + k, __float_as_uint(m), __ATOMIC_RELAXED, __HIP_MEMORY_SCOPE_AGENT); }
    for (int i = F.bx * NTHR + F.tid; i < 8192; i += F.G * NTHR) { const int pos = i >> 5, p = i & 31; const float inv = exp2f(-(float)p * (13.287712379549449f / 32.f)); const float ang = (float)pos * inv;
        FW(float, WS_ROPE)[i] = cosf(ang); (FW(float, WS_ROPE) + 8192)[i] = sinf(ang); }
    __syncthreads();
}

DI void cvt_item(const float* W, int K, int N, bf16* WT, int mode, LAS float* scr, int item, int lane) {
    const int nblk = N / 32, kb = item / nblk, nb = item % nblk, k0 = 128 * kb, n0 = 32 * nb;
    const int r0 = mode ? ((n0 >> 7) * 256 + (n0 & 127) + (mode == 2 ? 128 : 0)) : n0;
    const GAS float* Wg = (const GAS float*)W;
    float tv[64];
#pragma unroll
    for (int i = 0; i < 64; ++i) tv[i] = __builtin_nontemporal_load(Wg + (size_t)(k0 + 2 * i + (lane >> 5)) * N + n0 + (lane & 31));
#pragma unroll
    for (int i = 0; i < 64; ++i) scr[(2 * i + (lane >> 5)) * 33 + (lane & 31)] = tv[i];
    LDS_WAIT(); asm volatile("" ::: "memory");
    const int c = lane & 15;
#pragma unroll
    for (int j = 0; j < 8; ++j) { const int n = (lane >> 4) + 4 * j; const LAS float* s = scr + (8 * c) * 33 + n;
        v4u o; o.x = pk2(s[0 * 33], s[1 * 33]); o.y = pk2(s[2 * 33], s[3 * 33]); o.z = pk2(s[4 * 33], s[5 * 33]); o.w = pk2(s[6 * 33], s[7 * 33]);
        *(GAS v4u*)(WT + (size_t)(r0 + n) * K + k0 + 8 * c) = o; }
    LDS_WAIT(); asm volatile("" ::: "memory");
}
DI void cvt8_item(const float* W, int K, int N, unsigned char* WT, int mode, LAS float* scr, int item, int lane, float sc) {
    const int nblk = N / 32, kb = item / nblk, nb = item % nblk, k0 = 128 * kb, n0 = 32 * nb;
    const int r0 = mode ? ((n0 >> 7) * 256 + (n0 & 127) + (mode == 2 ? 128 : 0)) : n0;
    const GAS float* Wg = (const GAS float*)W;
    float tv[64];
#pragma unroll
    for (int i = 0; i < 64; ++i) tv[i] = __builtin_nontemporal_load(Wg + (size_t)(k0 + 2 * i + (lane >> 5)) * N + n0 + (lane & 31));
#pragma unroll
    for (int i = 0; i < 64; ++i) scr[(2 * i + (lane >> 5)) * 33 + (lane & 31)] = tv[i] * sc;
    LDS_WAIT(); asm volatile("" ::: "memory");
    const int c = lane & 7;
#pragma unroll
    for (int j = 0; j < 4; ++j) { const int n = (lane >> 3) + 8 * j; const LAS float* s = scr + (16 * c) * 33 + n;
        v4u o; o.x = pg8::pk4_fp8(s[0 * 33], s[1 * 33], s[2 * 33], s[3 * 33]); o.y = pg8::pk4_fp8(s[4 * 33], s[5 * 33], s[6 * 33], s[7 * 33]);
        o.z = pg8::pk4_fp8(s[8 * 33], s[9 * 33], s[10 * 33], s[11 * 33]); o.w = pg8::pk4_fp8(s[12 * 33], s[13 * 33], s[14 * 33], s[15 * 33]);
        *(GAS v4u*)(WT + (size_t)(r0 + n) * K + k0 + 16 * c) = o; }
    LDS_WAIT(); asm volatile("" ::: "memory");
}
constexpr int CVT_IW = 2816, CVT_IO = 1024, CVT8_IW = 2816, CVT_NMOE = 24 * CVT8_IW;
DI void cvt_moe_item(const Frame& F, int r, LAS float* scr) {
    const int mi = r / CVT8_IW, e = mi / 3, k = mi % 3; r -= mi * CVT8_IW;
    const float sc = pg8::f8_scale(((const unsigned*)(F.a->ws + WS_CTL))[CW_AMAX + mi]);
    if (k == 0) cvt8_item(F.a->in[I_M1] + (size_t)e * DM * DFF, DM, DFF, FW(unsigned char, WS_WM13) + (size_t)e * 2 * DFF * DM, 1, scr, r, F.lane, sc);
    else if (k == 1) cvt8_item(F.a->in[I_M3] + (size_t)e * DM * DFF, DM, DFF, FW(unsigned char, WS_WM13) + (size_t)e * 2 * DFF * DM, 2, scr, r, F.lane, sc);
    else cvt8_item(F.a->in[I_M2] + (size_t)e * DFF * DM, DFF, DM, FW(unsigned char, WS_WM2) + (size_t)e * DM * DFF, 0, scr, r, F.lane, sc);
}
DI void ph_cvt(const Frame& F0, int moe_hi) { const Frame F = launder(F0);
    for (int i = F.bx * NTHR + F.tid; i < 49152; i += F.G * NTHR) { const int l = i / 24576, r = i % 24576, s = r / 12288, j = r % 12288; float sum = F.a->in[I_ADAB][l * 12288 + j];
        for (int ks = 0; ks < 16; ++ks) sum += FW(float, WS_PART)[((size_t)(l * 16 + ks) * 2 + s) * 12288 + j];
        FW(float, WS_MODS)[i] = sum; }
    LAS float* scr = (LAS float*)(F.lds + F.wave * 17408);
    const int gw = F.bx * NWAVES + F.wave, NGW = F.G * NWAVES;
    constexpr int IW = CVT_IW, IO = CVT_IO; const int NIT = 2 * (IW + IO) + 3 * IW + moe_hi;
    for (int it = gw; it < NIT; it += NGW) {
        int r = NIT - 1 - it;
        if (r < IW) { cvt_item(F.a->in[I_WIN], DM, INC, FW(bf16, WS_WIN), 0, scr, r, F.lane); continue; } r -= IW;
        if (r < IO) { cvt_item(F.a->in[I_WOUT], DM, DM, FW(bf16, WS_WOUT), 0, scr, r, F.lane); continue; } r -= IO;
        if (r < IW) { cvt_item(F.a->in[I_F1], DM, DFF, FW(bf16, WS_WF13), 1, scr, r, F.lane); continue; } r -= IW;
        if (r < IW) { cvt_item(F.a->in[I_F3], DM, DFF, FW(bf16, WS_WF13), 2, scr, r, F.lane); continue; } r -= IW;
        if (r < IW) { cvt_item(F.a->in[I_F2], DFF, DM, FW(bf16, WS_WF2), 0, scr, r, F.lane); continue; } r -= IW;
        if (r < IW) { cvt_item(F.a->in[I_WIN] + (size_t)DM * INC, DM, INC, FW(bf16, WS_WIN) + (size_t)INC * DM, 0, scr, r, F.lane); continue; } r -= IW;
        if (r < IO) { cvt_item(F.a->in[I_WOUT] + (size_t)DM * DM, DM, DM, FW(bf16, WS_WOUT) + (size_t)DM * DM, 0, scr, r, F.lane); continue; } r -= IO;
        if (r < moe_hi) cvt_moe_item(F, r, scr);
    }
    __syncthreads();
}
DI void cvt_moe_range(const Frame& F0, int lo, int hi, int wv, int nw) { const Frame F = launder(F0);
    LAS float* scr = (LAS float*)(F.lds + F.wave * 17408);
    for (int r = lo + wv; r < hi; r += nw) cvt_moe_item(F, r, scr);
    __syncthreads();
}

DI void ph_norm(const Frame& F0, int l, int which, int nrb, bool route) { const Frame F = launder(F0);
    LAS float* vA = (LAS float*)F.lds;
    LAS float* rwT = (LAS float*)(F.lds + 32768);
    LAS int* hist = (LAS int*)(F.lds + SCR_OFF);
    const float* g = F.a->in[which ? I_N2G : I_N1G] + l * DM;
    const float* md = FW(float, WS_MODS) + (size_t)l * 24576;
    for (int i = F.tid; i < 4096; i += NTHR) { const int s = i >> 11, d = i & 2047; const float sh = md[s * 12288 + (which * 3) * 2048 + d], scl = md[s * 12288 + (which * 3 + 1) * 2048 + d];
        vA[i] = g[d] * (1.f + scl); vA[4096 + i] = sh; }
    if (route) for (int i = F.tid; i < 4096; i += NTHR) { const int d = i >> 1, hh = i & 1; const f32x4 v = *(const f32x4*)(F.a->in[I_RW] + d * 8 + hh * 4);
        rwT[(hh * 4 + 0) * 2048 + d] = v.x; rwT[(hh * 4 + 1) * 2048 + d] = v.y; rwT[(hh * 4 + 2) * 2048 + d] = v.z; rwT[(hh * 4 + 3) * 2048 + d] = v.w; }
    __syncthreads();
    const bool first = (l == 0 && which == 0);
    const float* xc = (l == 0) ? F.a->in[I_CTX] : FW(float, WS_XCTX);
    v4u* SEL = (v4u*)(F.a->ws + WS_SEL); int* RBCNT = (int*)(F.a->ws + WS_RBCNT);
    const bool spread = (F.G == 256 && nrb == NROW / 64);
    for (int rb = F.bx; rb < (spread ? SEQ / 64 : nrb); rb += F.G) {
        if (route) { if (F.tid < 8) hist[F.tid] = 0; __syncthreads(); }
        for (int i = 0; i < (spread ? 9 : 8); ++i) {
            if (i == 8 && F.wave != 0) break;
            const int r = i == 8 ? SEQ + F.bx : rb * 64 + F.wave * 8 + i; const int s = r >= SEQ ? 1 : 0;
            f32x4 v[8]; float ss = 0.f;
            if (s || first) { const GAS f32x4* xr = (const GAS f32x4*)(s ? xc + (size_t)(r - SEQ) * DM : F.a->in[I_X] + (size_t)r * DM) + F.lane;
#pragma unroll
                for (int j = 0; j < 8; ++j) v[j] = xr[64 * j]; }
            else { const GAS v2u* xr = (const GAS v2u*)(FW(bf16, WS_XB) + (size_t)r * DM) + F.lane;
#pragma unroll
                for (int j = 0; j < 8; ++j) { const v2u w = xr[64 * j]; v[j] = (f32x4){bflo(w.x), bfhi(w.x), bflo(w.y), bfhi(w.y)}; } }
            if (s && l == 0 && which == 1) {
                const float* gt = md + 12288 + 2 * 2048; GAS f32x4* xw = (GAS f32x4*)(FW(float, WS_XCTX) + (size_t)(r - SEQ) * DM) + F.lane;
#pragma unroll
                for (int j = 0; j < 8; ++j) { f32x4 a = (f32x4){0.f, 0.f, 0.f, 0.f};
                    for (int sl = 0; sl < 8; ++sl) a += *((const GAS f32x4*)(FW(float, WS_PC1) + ((size_t)sl * 256 + (r - SEQ)) * DM) + F.lane + 64 * j);
                    v[j] = v[j] + *(const f32x4*)(gt + 4 * F.lane + 256 * j) * a; xw[64 * j] = v[j]; } }
            if (s && l == 1 && which == 0) {
                const float* gt = FW(float, WS_MODS) + 12288 + 5 * 2048;
#pragma unroll
                for (int j = 0; j < 8; ++j) { f32x4 a = (f32x4){0.f, 0.f, 0.f, 0.f};
                    for (int sl = 0; sl < 11; ++sl) a += *((const GAS f32x4*)(FW(float, WS_PC2) + ((size_t)sl * 256 + (r - SEQ)) * DM) + F.lane + 64 * j);
                    v[j] = v[j] + *(const f32x4*)(gt + 4 * F.lane + 256 * j) * a; } }
#pragma unroll
            for (int j = 0; j < 8; ++j) ss += (v[j].x * v[j].x + v[j].y * v[j].y) + (v[j].z * v[j].z + v[j].w * v[j].w);
            const float rstd = 1.f / sqrtf(wave_sum(ss) * (1.f / DM) + EPS);
            GAS v2u* o = (GAS v2u*)(FW(bf16, WS_H) + (size_t)r * DM) + F.lane; GAS unsigned* o8 = (GAS unsigned*)(FW(unsigned char, WS_H) + (size_t)r * DM) + F.lane;
#pragma unroll
            for (int j = 0; j < 8; ++j) { const f32x4 a = *(const LAS f32x4*)(vA + s * 2048 + 4 * F.lane + 256 * j), b = *(const LAS f32x4*)(vA + 4096 + s * 2048 + 4 * F.lane + 256 * j);
                v[j] = v[j] * rstd * a + b;
                if (route) o8[64 * j] = pg8::pk4_fp8(v[j].x * F8_SH, v[j].y * F8_SH, v[j].z * F8_SH, v[j].w * F8_SH);
                else { v2u w; w.x = pk2(v[j].x, v[j].y); w.y = pk2(v[j].z, v[j].w); o[64 * j] = w; } }
            if (route) {
                float lg[8];
#pragma unroll
                for (int e = 0; e < 8; ++e) { float t = 0.f;
#pragma unroll
                    for (int j = 0; j < 8; ++j) { const f32x4 w = *(const LAS f32x4*)(rwT + e * 2048 + 4 * F.lane + 256 * j); t += (v[j].x * w.x + v[j].y * w.y) + (v[j].z * w.z + v[j].w * w.w); }
                    lg[e] = wave_sum(t) + F.a->in[I_RB][e]; }
                int e0 = 0; float v0 = lg[0];
#pragma unroll
                for (int e = 1; e < 8; ++e) if (lg[e] > v0) { v0 = lg[e]; e0 = e; }
                int e1 = -1; float v1 = -3.0e38f;
#pragma unroll
                for (int e = 0; e < 8; ++e) if (e != e0 && lg[e] > v1) { v1 = lg[e]; e1 = e; }
                if (e1 < 0) { e1 = (e0 + 1) & 7; v1 = v0; }
                const float g0 = 1.f / (1.f + expf(v1 - v0)), g1 = 1.f - g0;
                if (F.lane == 0) { v4u sv; sv.x = (unsigned)e0 | ((unsigned)e1 << 8); sv.y = __float_as_uint(g0); sv.z = __float_as_uint(g1); sv.w = 0u; SEL[r] = sv;
                    __hip_atomic_fetch_add(hist + e0, 1, __ATOMIC_RELAXED, __HIP_MEMORY_SCOPE_WORKGROUP); __hip_atomic_fetch_add(hist + e1, 1, __ATOMIC_RELAXED, __HIP_MEMORY_SCOPE_WORKGROUP); }
            }
        }
        if (route) { __syncthreads(); if (F.tid < 8) RBCNT[rb * 8 + F.tid] = hist[F.tid]; __syncthreads(); }
    }
    __syncthreads();
}


DI void unpk8(const v4u w, float (&v)[8]) { v[0] = bflo(w.x); v[1] = bfhi(w.x); v[2] = bflo(w.y); v[3] = bfhi(w.y); v[4] = bflo(w.z); v[5] = bfhi(w.z); v[6] = bflo(w.w); v[7] = bfhi(w.w); }
DI v4u pk8(const float (&v)[8]) { v4u w; w.x = pk2(v[0], v[1]); w.y = pk2(v[2], v[3]); w.z = pk2(v[4], v[5]); w.w = pk2(v[6], v[7]); return w; }
DI void rope8(float (&x1)[8], float (&x2)[8], const float* tab) {
    const f32x4 c0 = *(const GAS f32x4*)tab, c1 = *(const GAS f32x4*)(tab + 4), s0 = *(const GAS f32x4*)(tab + 8192), s1 = *(const GAS f32x4*)(tab + 8196);
    const float cs[8] = {c0.x, c0.y, c0.z, c0.w, c1.x, c1.y, c1.z, c1.w}, sn[8] = {s0.x, s0.y, s0.z, s0.w, s1.x, s1.y, s1.z, s1.w};
#pragma unroll
    for (int i = 0; i < 8; ++i) { const float a = x1[i], b = x2[i]; x1[i] = a * cs[i] - b * sn[i]; x2[i] = b * cs[i] + a * sn[i]; }
}

DI int tokp(int tok) { return (tok & ~31) | (((tok >> 2) & 3) << 3) | (((tok >> 4) & 1) << 2) | (tok & 3); }
DI void prep_src(int it, int& blk, int& kind, int& h, int& cb) {
    blk = it >> 2; const int hs = it & 3;
    if (hs < 2) { kind = 1; h = hs; cb = C_KA; } else { kind = 2; h = hs - 2; cb = C_VA; }
    cb += h * 128;
}
DI void ph_prep(const Frame& F0, int l) { const Frame F = launder(F0);
    LAS unsigned char* T = F.lds;
    const int t = F.tid, tok = t >> 2, q = t & 3;
    const float* kg = F.a->in[I_KG] + l * HD;
    f32x4 kgv[4][2];
#pragma unroll
    for (int c = 0; c < 4; ++c) { kgv[c][0] = *(const f32x4*)(kg + 32 * c + 8 * q); kgv[c][1] = *(const f32x4*)(kg + 32 * c + 8 * q + 4); }
    const int NIT = NBLK * 4;
    v4u cur[4];
    { int blk, kind, h, cb; if (F.bx < NIT) { prep_src(F.bx, blk, kind, h, cb); const bf16* rp = FW(bf16, WS_PROJ) + (size_t)(blk * 128 + tok) * INC + cb + 8 * q;
#pragma unroll
        for (int c = 0; c < 4; ++c) cur[c] = *(const GAS v4u*)(rp + 32 * c); } }
    for (int it = F.bx; it < NIT; it += F.G) {
        int blk, kind, h, cb; prep_src(it, blk, kind, h, cb); const bool lat = blk < 128;
        const int row = blk * 128 + tok;
        bf16* rp = FW(bf16, WS_PROJ) + (size_t)row * INC + cb + 8 * q;
        v4u nxt[4];
        if (it + F.G < NIT) { int b2, k2, h2, c2; prep_src(it + F.G, b2, k2, h2, c2); const bf16* rp2 = FW(bf16, WS_PROJ) + (size_t)(b2 * 128 + tok) * INC + c2 + 8 * q;
#pragma unroll
            for (int c = 0; c < 4; ++c) nxt[c] = *(const GAS v4u*)(rp2 + 32 * c); }
        v4u w[4];
        if (kind == 1) {
            float v[4][8];
#pragma unroll
            for (int c = 0; c < 4; ++c) unpk8(cur[c], v[c]);
            {
                float ss = 0.f;
#pragma unroll
                for (int c = 0; c < 4; ++c)
#pragma unroll
                    for (int i = 0; i < 8; ++i) ss += v[c][i] * v[c][i];
                ss += __shfl_xor(ss, 1); ss += __shfl_xor(ss, 2);
                const float rstd = 1.f / sqrtf(ss * (1.f / HD) + EPS);
#pragma unroll
                for (int c = 0; c < 4; ++c) { const float gg[8] = {kgv[c][0].x, kgv[c][0].y, kgv[c][0].z, kgv[c][0].w, kgv[c][1].x, kgv[c][1].y, kgv[c][1].z, kgv[c][1].w};
#pragma unroll
                    for (int i = 0; i < 8; ++i) v[c][i] *= rstd * gg[i]; }
            }
            if (lat) { rope8(v[0], v[1], FW(float, WS_ROPE) + (row >> 6) * 32 + 8 * q); rope8(v[2], v[3], FW(float, WS_ROPE) + (row & 63) * 32 + 8 * q); }
#pragma unroll
            for (int c = 0; c < 4; ++c) { w[c] = pk8(v[c]); *(GAS v4u*)(rp + 32 * c) = w[c]; }
        } else {
#pragma unroll
            for (int c = 0; c < 4; ++c) w[c] = cur[c];
        }
        if (kind != 1) {
#pragma unroll
            for (int c = 0; c < 4; ++c) { const unsigned ww[4] = {w[c].x, w[c].y, w[c].z, w[c].w};
#pragma unroll
                for (int i = 0; i < 8; ++i) *(LAS bf16*)(T + (32 * c + 8 * q + i) * 272 + tokp(tok) * 2) = (bf16)((i & 1) ? (ww[i >> 1] >> 16) : (ww[i >> 1] & 0xffffu)); }
            __syncthreads();
            bf16* dst = FW(bf16, WS_VAT) + (size_t)(blk * 2 + h) * 16384;
#pragma unroll
            for (int k = 0; k < 4; ++k) { const int id = t + 512 * k, d = id >> 4, tc = id & 15; const v4u x = *(const LAS v4u*)(T + d * 272 + tc * 16); *(GAS v4u*)(dst + d * 128 + tc * 8) = x; }
            __syncthreads();
        }
#pragma unroll
        for (int c = 0; c < 4; ++c) cur[c] = nxt[c];
    }
    __syncthreads();
}

DI int attn_tile_blk(int b, int ti) { return ti < 2 ? 128 + ti : b - 1 + (ti - 2); }
DI bool attn_tile_valid(int b, int ti) { if (ti < 2) return true; const int kb = b - 1 + (ti - 2); return kb >= 0 && kb < 128; }
DI void attn_load(const Frame& F, int b, int kvh, int ti, v4u (&kr)[4], v4u (&vr)[4]) {
    const int kb = attn_tile_blk(b, ti);
#pragma unroll
    for (int i = 0; i < 4; ++i) { const int id = F.tid + 512 * i, key = id >> 4, dc = id & 15; kr[i] = *(const GAS v4u*)(FW(bf16, WS_PROJ) + (size_t)(kb * 128 + key) * INC + C_KA + kvh * 128 + dc * 8); }
#pragma unroll
    for (int i = 0; i < 4; ++i) { const int id = F.tid + 512 * i, d = id >> 4, kc = id & 15; vr[i] = *(const GAS v4u*)(FW(bf16, WS_VAT) + ((size_t)(kb * 2 + kvh) * 128 + d) * 128 + kc * 8); }
}
DI void attn_item(const Frame& F0, int l, int b, int kvh, int pair, float m2) { const Frame F = launder(F0);
    const int w = F.wave, lane = F.lane, fr = lane & 15, fq = lane >> 4;
    LAS unsigned char* Ks = F.lds; LAS unsigned char* Vs = F.lds + 34816;
    const int head = kvh * 4 + pair * 2 + (w >> 2);
    const int qrow0 = b * 128 + (w & 3) * 32;
    bf16x8 Q[2][4];
    const float c1 = 0.08838834764831845f * 1.44269504089f;
    { const float* qg = F.a->in[I_QG] + l * HD;
#pragma unroll
      for (int qt = 0; qt < 2; ++qt) { const int row = qrow0 + qt * 16 + fr; float v[4][8]; float ss = 0.f;
#pragma unroll
        for (int ks = 0; ks < 4; ++ks) { unpk8(*(const GAS v4u*)(FW(bf16, WS_PROJ) + (size_t)row * INC + C_QA + head * 128 + ks * 32 + fq * 8), v[ks]);
#pragma unroll
            for (int i = 0; i < 8; ++i) ss += v[ks][i] * v[ks][i]; }
        ss += __shfl_xor(ss, 16); ss += __shfl_xor(ss, 32);
        const float rs = c1 / sqrtf(ss * (1.f / HD) + EPS);
#pragma unroll
        for (int ks = 0; ks < 4; ++ks) { const f32x4 g0 = *(const f32x4*)(qg + ks * 32 + fq * 8), g1 = *(const f32x4*)(qg + ks * 32 + fq * 8 + 4); const float gg[8] = {g0.x, g0.y, g0.z, g0.w, g1.x, g1.y, g1.z, g1.w};
#pragma unroll
            for (int i = 0; i < 8; ++i) v[ks][i] *= rs * gg[i]; }
        if (b < 128) { rope8(v[0], v[1], FW(float, WS_ROPE) + (row >> 6) * 32 + 8 * fq); rope8(v[2], v[3], FW(float, WS_ROPE) + (row & 63) * 32 + 8 * fq); }
#pragma unroll
        for (int ks = 0; ks < 4; ++ks) Q[qt][ks] = __builtin_bit_cast(bf16x8, pk8(v[ks])); } }
    f32x4 O[8][2];
#pragma unroll
    for (int dt = 0; dt < 8; ++dt) { O[dt][0] = (f32x4){0.f, 0.f, 0.f, 0.f}; O[dt][1] = O[dt][0]; }
    float ls[2] = {0.f, 0.f};
    const int nt = b >= 128 ? 2 : 5;
    v4u kr[4], vr[4];
    if (w & 1) __builtin_amdgcn_s_setprio(2);
    int ti = 0; attn_load(F, b, kvh, 0, kr, vr);
    for (;;) {
#pragma unroll
        for (int i = 0; i < 4; ++i) { const int id = F.tid + 512 * i; const int lo = (id >> 4) * 272 + (id & 15) * 16; *(LAS v4u*)(Ks + lo) = kr[i]; *(LAS v4u*)(Vs + lo) = vr[i]; }
        int nx = ti + 1; while (nx < nt && !attn_tile_valid(b, nx)) ++nx;
        __syncthreads();
        if (nx < nt) attn_load(F, b, kvh, nx, kr, vr);
        const int kstart = attn_tile_blk(b, ti) * 128;
        const bool edge = ti == 2 || ti == 4;
#pragma nounroll
        for (int hf = 0; hf < 2; ++hf) {
            f32x4 S[4][2];
#pragma unroll
            for (int kt = 0; kt < 4; ++kt) { S[kt][0] = (f32x4){-m2, -m2, -m2, -m2}; S[kt][1] = S[kt][0]; }
#pragma unroll
            for (int ks = 0; ks < 4; ++ks)
#pragma unroll
                for (int kt = 0; kt < 4; ++kt) { const bf16x8 kf = *(const LAS bf16x8*)(Ks + (64 * hf + 16 * kt + fr) * 272 + ks * 64 + fq * 16);
                    S[kt][0] = MFMA16(kf, Q[0][ks], S[kt][0]); S[kt][1] = MFMA16(kf, Q[1][ks], S[kt][1]); }
            if (edge) {
#pragma unroll
                for (int qt = 0; qt < 2; ++qt) { const int qpos = qrow0 + qt * 16 + fr;
#pragma unroll
                    for (int kt = 0; kt < 4; ++kt)
#pragma unroll
                        for (int rg = 0; rg < 4; ++rg) { float p = ex2(S[kt][qt][rg]); const int dd = qpos - (kstart + 64 * hf + 16 * kt + 4 * fq + rg); if (dd > 128 || dd < -128) p = 0.f; S[kt][qt][rg] = p; ls[qt] += p; } }
            } else {
#pragma unroll
                for (int qt = 0; qt < 2; ++qt)
#pragma unroll
                    for (int kt = 0; kt < 4; ++kt)
#pragma unroll
                        for (int rg = 0; rg < 4; ++rg) { const float p = ex2(S[kt][qt][rg]); S[kt][qt][rg] = p; ls[qt] += p; }
            }
            bf16x8 P[2][2];
#pragma unroll
            for (int qt = 0; qt < 2; ++qt)
#pragma unroll
                for (int s2 = 0; s2 < 2; ++s2) { v4u pw; pw.x = pk2(S[2 * s2][qt][0], S[2 * s2][qt][1]); pw.y = pk2(S[2 * s2][qt][2], S[2 * s2][qt][3]);
                    pw.z = pk2(S[2 * s2 + 1][qt][0], S[2 * s2 + 1][qt][1]); pw.w = pk2(S[2 * s2 + 1][qt][2], S[2 * s2 + 1][qt][3]); P[qt][s2] = __builtin_bit_cast(bf16x8, pw); }
#pragma unroll
            for (int s2 = 0; s2 < 2; ++s2)
#pragma unroll
                for (int dt = 0; dt < 8; ++dt) { const bf16x8 vf = *(const LAS bf16x8*)(Vs + (16 * dt + fr) * 272 + (64 * hf + 32 * s2 + 8 * fq) * 2);
                    O[dt][0] = MFMA16(vf, P[0][s2], O[dt][0]); O[dt][1] = MFMA16(vf, P[1][s2], O[dt][1]); }
        }
        __syncthreads();
        if (nx >= nt) break;
        ti = nx;
    }
    __builtin_amdgcn_s_setprio(0);
    const float sk = F.a->in[I_SINK][l * 8 + head];
#pragma unroll
    for (int qt = 0; qt < 2; ++qt) { float s = ls[qt]; s += __shfl_xor(s, 16); s += __shfl_xor(s, 32); const float inv = 1.f / (s + ex2(sk * 1.44269504089f - m2));
        bf16* op = FW(bf16, WS_MIX) + (size_t)(qrow0 + qt * 16 + fr) * DM + head * 128 + 4 * fq;
#pragma unroll
        for (int dt = 0; dt < 8; ++dt) { const f32x4 o = O[dt][qt] * inv; v2u wv; wv.x = pk2(o.x, o.y); wv.y = pk2(o.z, o.w); *(GAS v2u*)(op + 16 * dt) = wv; } }
}

DI void fkv_load(const Frame& F, int it, v4u (&kc)[4], v4u (&vc)[4]) {
    const int cz = it >> 3, h = it & 7, tok = F.tid >> 2, q = F.tid & 3; const bf16* rp = FW(bf16, WS_PROJ) + (size_t)(cz * 128 + tok) * INC + h * 128 + 8 * q;
#pragma unroll
    for (int c = 0; c < 4; ++c) { kc[c] = *(const GAS v4u*)(rp + C_KR + 32 * c); vc[c] = *(const GAS v4u*)(rp + C_VR + 32 * c); }
}
DI void fkv_item(const Frame& F0, int cz, int h, float lgf2, float lgb2, int nxt, v4u (&kc)[4], v4u (&vc)[4]) { const Frame F = launder(F0);
    const int w = F.wave, lane = F.lane, fr = lane & 15, fq = lane >> 4, t = F.tid, tok = t >> 2, q = t & 3;
    LAS unsigned char* T1 = F.lds; LAS unsigned char* T2 = F.lds + 34816;
    const int row = cz * 128 + tok;
    { float v[4][8];
#pragma unroll
      for (int c = 0; c < 4; ++c) unpk8(kc[c], v[c]);
      if (cz < 128) { rope8(v[0], v[1], FW(float, WS_ROPE) + (row >> 6) * 32 + 8 * q); rope8(v[2], v[3], FW(float, WS_ROPE) + (row & 63) * 32 + 8 * q); }
      bf16* rp = FW(bf16, WS_PROJ) + (size_t)row * INC + C_KR + h * 128 + 8 * q;
#pragma unroll
      for (int c = 0; c < 4; ++c) {
#pragma unroll
          for (int i = 0; i < 8; ++i) v[c][i] *= 0.08838834764831845f;
          const v4u kw = pk8(v[c]); *(GAS v4u*)(rp + 32 * c) = kw;
          const unsigned k4[4] = {kw.x, kw.y, kw.z, kw.w}, v4[4] = {vc[c].x, vc[c].y, vc[c].z, vc[c].w};
#pragma unroll
          for (int i = 0; i < 8; ++i) { const int d = 32 * c + 8 * q + i;
              *(LAS bf16*)(T1 + d * 272 + tokp(tok) * 2) = (bf16)((i & 1) ? (k4[i >> 1] >> 16) : (k4[i >> 1] & 0xffffu));
              *(LAS bf16*)(T2 + d * 272 + tokp(tok) * 2) = (bf16)((i & 1) ? (v4[i >> 1] >> 16) : (v4[i >> 1] & 0xffffu)); } } }
    __syncthreads();
    if (nxt >= 0) fkv_load(F, nxt, kc, vc);
    { bf16* dst = FW(bf16, WS_VRT) + (size_t)(cz * 8 + h) * 16384;
#pragma unroll
      for (int k = 0; k < 4; ++k) { const int id = t + 512 * k, d = id >> 4, tc = id & 15; *(GAS v4u*)(dst + d * 128 + tc * 8) = *(const LAS v4u*)(T2 + d * 272 + tc * 16); } }
    bf16x8 Xf[4], Xb[4];
#pragma unroll
    for (int ks = 0; ks < 4; ++ks) { const v4u x = *(const LAS v4u*)(T2 + (16 * w + fr) * 272 + (32 * ks + 8 * fq) * 2); const unsigned xw[4] = {x.x, x.y, x.z, x.w}; v4u of, ob; unsigned rf[4], rb[4];
#pragma unroll
        for (int i = 0; i < 4; ++i) { const int j = 32 * ks + 16 * (i >> 1) + 4 * fq + 2 * (i & 1); const float a = bflo(xw[i]), b = bfhi(xw[i]);
            rf[i] = pk2(a * ex2((float)(127 - j) * lgf2), b * ex2((float)(126 - j) * lgf2)); rb[i] = pk2(a * ex2((float)j * lgb2), b * ex2((float)(j + 1) * lgb2)); }
        of.x = rf[0]; of.y = rf[1]; of.z = rf[2]; of.w = rf[3]; ob.x = rb[0]; ob.y = rb[1]; ob.z = rb[2]; ob.w = rb[3];
        Xf[ks] = __builtin_bit_cast(bf16x8, of); Xb[ks] = __builtin_bit_cast(bf16x8, ob); }
    f32x4 af[8], ab[8];
#pragma unroll
    for (int dt = 0; dt < 8; ++dt) { af[dt] = (f32x4){0.f, 0.f, 0.f, 0.f}; ab[dt] = af[dt]; }
#pragma unroll
    for (int ks = 0; ks < 4; ++ks)
#pragma unroll
        for (int dt = 0; dt < 8; ++dt) { const bf16x8 yf = *(const LAS bf16x8*)(T1 + (16 * dt + fr) * 272 + ks * 64 + fq * 16); af[dt] = MFMA16(yf, Xf[ks], af[dt]); ab[dt] = MFMA16(yf, Xb[ks], ab[dt]); }
    bf16* o = FW(bf16, WS_KV) + ((size_t)((cz * 8 + h) * 2) * 128 + 16 * w + fr) * 128 + 4 * fq;
#pragma unroll
    for (int dt = 0; dt < 8; ++dt) { v2u a, b; a.x = pk2_safe(af[dt].x, af[dt].y); a.y = pk2_safe(af[dt].z, af[dt].w); b.x = pk2_safe(ab[dt].x, ab[dt].y); b.y = pk2_safe(ab[dt].z, ab[dt].w);
        *(GAS v2u*)(o + 16 * dt) = a; *(GAS v2u*)(o + 16384 + 16 * dt) = b; }
    __syncthreads();
}
DI float log2_gamma(const Frame& F, int l, int dir, int h) { const float x = F.a->in[I_DECAY][(l * 2 + dir) * 8 + h]; return -log1pf(expf(-x)) * 1.44269504089f; }

DI void ph_prep_kv(const Frame& F0, int l) { const Frame F = launder(F0);
    ph_prep(F0, l);
    const int NKV = NBLK * 8;
    v4u kc[4], vc[4];
    int it = F.G - 1 - F.bx;
    if (it < NKV) fkv_load(F, it, kc, vc);
    for (; it < NKV; it += F.G) { const int cz = it >> 3, h = it & 7; fkv_item(F0, cz, h, log2_gamma(F, l, 0, h), log2_gamma(F, l, 1, h), it + F.G < NKV ? it + F.G : -1, kc, vc); }
    __syncthreads();
}

DI void scan_share(const Frame& F0, int l, int s, int SG) { const Frame F = launder(F0);
    for (int idx = s * NTHR + F.tid; idx < 131072; idx += 2 * SG * NTHR) {
        const int idx2 = idx + SG * NTHR; const bool two = idx2 < 131072; const int jdx = two ? idx2 : idx;
        const int h = idx >> 14, dir = (idx >> 13) & 1, h2 = jdx >> 14, dir2 = (jdx >> 13) & 1;
        const float dec = ex2(128.f * log2_gamma(F, l, dir, h)), dec2 = ex2(128.f * log2_gamma(F, l, dir2, h2));
        const size_t base = ((size_t)(h * 2 + dir) * 128 + ((idx >> 6) & 127)) * 128 + (idx & 63) * 2, base2 = ((size_t)(h2 * 2 + dir2) * 128 + ((jdx >> 6) & 127)) * 128 + (jdx & 63) * 2;
        float s0 = 0.f, s1 = 0.f, t0 = 0.f, t1 = 0.f;
        for (int st = 0; st < 130; st += 10) {
            unsigned kv[10], kw[10];
#pragma unroll
            for (int u = 0; u < 10; ++u) { const int step = st + u; const int cz = dir ? 129 - step : (step < 2 ? 128 + step : step - 2), cz2 = dir2 ? 129 - step : (step < 2 ? 128 + step : step - 2);
                kv[u] = *(const GAS unsigned*)(FW(bf16, WS_KV) + (size_t)cz * 262144 + base); kw[u] = *(const GAS unsigned*)(FW(bf16, WS_KV) + (size_t)cz2 * 262144 + base2); }
#pragma unroll
            for (int u = 0; u < 10; ++u) { const int step = st + u; const int cz = dir ? 129 - step : (step < 2 ? 128 + step : step - 2), cz2 = dir2 ? 129 - step : (step < 2 ? 128 + step : step - 2);
                *(GAS unsigned*)(FW(bf16, WS_SPREV) + (size_t)cz * 262144 + base) = pk2(s0, s1); s0 = dec * s0 + bflo(kv[u]); s1 = dec * s1 + bfhi(kv[u]);
                if (two) { *(GAS unsigned*)(FW(bf16, WS_SPREV) + (size_t)cz2 * 262144 + base2) = pk2(t0, t1); t0 = dec2 * t0 + bflo(kw[u]); t1 = dec2 * t1 + bfhi(kw[u]); } }
        }
    }
}

DI void ld_tile128(LAS unsigned char* dst, const bf16* src, int pitch_elems, int tid) {
#pragma unroll
    for (int k = 0; k < 4; ++k) { const int id = tid + 512 * k, r = id >> 4, c = id & 15; *(LAS v4u*)(dst + r * 272 + c * 16) = *(const GAS v4u*)(src + (size_t)r * pitch_elems + c * 8); }
}
DI void ret_ld_pair(const bf16* a, int pa, const bf16* b, int pb, int tid, v4u (&R)[8]) {
#pragma unroll
    for (int k = 0; k < 4; ++k) { const int id = tid + 512 * k, r = id >> 4, c = id & 15; R[k] = *(const GAS v4u*)(a + (size_t)r * pa + c * 8); R[4 + k] = *(const GAS v4u*)(b + (size_t)r * pb + c * 8); }
}
DI void ret_st_pair(LAS unsigned char* A, LAS unsigned char* B, int tid, const v4u (&R)[8]) {
#pragma unroll
    for (int k = 0; k < 4; ++k) { const int id = tid + 512 * k, r = id >> 4, c = id & 15; const int lo = r * 272 + c * 16; *(LAS v4u*)(A + lo) = R[k]; *(LAS v4u*)(B + lo) = R[4 + k]; }
}
DI void ret_ld_state(const Frame& F, int it, v4u (&R)[8]) { const int cz = it >> 3, h = it & 7; const bf16* s2 = FW(bf16, WS_SPREV) + (size_t)cz * 262144 + (size_t)(h * 2) * 16384; ret_ld_pair(s2, 128, s2 + 16384, 128, F.tid, R); }
DI void ret_ld_kv(const Frame& F, int it, v4u (&R)[8]) { const int cz = it >> 3, h = it & 7; ret_ld_pair(FW(bf16, WS_PROJ) + (size_t)(cz * 128) * INC + C_KR + h * 128, INC, FW(bf16, WS_VRT) + (size_t)(cz * 8 + h) * 16384, 128, F.tid, R); }
DI void ret_item(const Frame& F0, int l, int it, int nxt, v4u (&R)[8]) { const Frame F = launder(F0);
    const int w = F.wave, lane = F.lane, fr = lane & 15, fq = lane >> 4;
    LAS unsigned char* Kn = F.lds; LAS unsigned char* Vt = F.lds + 34816; LAS unsigned char* Sf = F.lds + 2 * 34816; LAS unsigned char* Sb = F.lds + 3 * 34816;
    const int cz = it >> 3, h = it & 7, row0 = cz * 128;
    const float lgf2 = log2_gamma(F, l, 0, h), lgb2 = log2_gamma(F, l, 1, h);
    const int i = 16 * w + fr;
    const bf16* qp = FW(bf16, WS_PROJ) + (size_t)(row0 + i) * INC;
    bf16x8 Qf[4];
    { v4u qw[4];
#pragma unroll
      for (int ks = 0; ks < 4; ++ks) qw[ks] = *(const GAS v4u*)(qp + C_QR + h * 128 + 32 * ks + 8 * fq);
      if (nxt >= 0) ret_ld_state(F, nxt, R);
      if (cz < 128) { float v[4][8];
#pragma unroll
        for (int ks = 0; ks < 4; ++ks) unpk8(qw[ks], v[ks]);
        const int row = row0 + i; rope8(v[0], v[1], FW(float, WS_ROPE) + (row >> 6) * 32 + 8 * fq); rope8(v[2], v[3], FW(float, WS_ROPE) + (row & 63) * 32 + 8 * fq);
#pragma unroll
        for (int ks = 0; ks < 4; ++ks) qw[ks] = pk8(v[ks]); }
#pragma unroll
      for (int ks = 0; ks < 4; ++ks) Qf[ks] = __builtin_bit_cast(bf16x8, qw[ks]); }
    f32x4 Y[8];
    { f32x4 CF[8], CB[8];
#pragma unroll
      for (int et = 0; et < 8; ++et) { CF[et] = (f32x4){0.f, 0.f, 0.f, 0.f}; CB[et] = CF[et]; }
#pragma unroll
      for (int ks = 0; ks < 4; ++ks) { bf16x8 sfv[8], sbv[8];
#pragma unroll
        for (int et = 0; et < 8; ++et) { sfv[et] = *(const LAS bf16x8*)(Sf + (16 * et + fr) * 272 + ks * 64 + fq * 16); sbv[et] = *(const LAS bf16x8*)(Sb + (16 * et + fr) * 272 + ks * 64 + fq * 16); }
        __builtin_amdgcn_sched_barrier(0);
#pragma unroll
        for (int et = 0; et < 8; ++et) { CF[et] = MFMA16(sfv[et], Qf[ks], CF[et]); CB[et] = MFMA16(sbv[et], Qf[ks], CB[et]); }
        __builtin_amdgcn_sched_barrier(0); }
      const float cf = ex2((float)(i + 1) * lgf2), cb = ex2((float)(128 - i) * lgb2);
#pragma unroll
      for (int et = 0; et < 8; ++et) Y[et] = cf * CF[et] + cb * CB[et];
    }
    __syncthreads();
    if (nxt >= 0) { ret_st_pair(Sf, Sb, F.tid, R); ret_ld_kv(F, nxt, R); }
    f32x4 S[8];
#pragma unroll
    for (int jt = 0; jt < 8; ++jt) S[jt] = (f32x4){0.f, 0.f, 0.f, 0.f};
#pragma unroll
    for (int ks = 0; ks < 4; ks += 2) { bf16x8 kfv[2][8];
#pragma unroll
        for (int k2 = 0; k2 < 2; ++k2)
#pragma unroll
            for (int jt = 0; jt < 8; ++jt) kfv[k2][jt] = *(const LAS bf16x8*)(Kn + (16 * jt + fr) * 272 + (ks + k2) * 64 + fq * 16);
        __builtin_amdgcn_sched_barrier(0);
#pragma unroll
        for (int k2 = 0; k2 < 2; ++k2)
#pragma unroll
            for (int jt = 0; jt < 8; ++jt) S[jt] = MFMA16(kfv[k2][jt], Qf[ks + k2], S[jt]);
        __builtin_amdgcn_sched_barrier(0); }
#pragma unroll
    for (int jt = 0; jt < 8; ++jt)
#pragma unroll
        for (int rg = 0; rg < 4; ++rg) { const int dl = i - (16 * jt + 4 * fq + rg); const float wgt = dl > 0 ? ex2((float)dl * lgf2) : (dl < 0 ? ex2((float)(-dl) * lgb2) : 2.f); S[jt][rg] *= wgt; }
    bf16x8 P[4];
#pragma unroll
    for (int s4 = 0; s4 < 4; ++s4) { v4u pw; pw.x = pk2(S[2 * s4][0], S[2 * s4][1]); pw.y = pk2(S[2 * s4][2], S[2 * s4][3]); pw.z = pk2(S[2 * s4 + 1][0], S[2 * s4 + 1][1]); pw.w = pk2(S[2 * s4 + 1][2], S[2 * s4 + 1][3]);
        P[s4] = __builtin_bit_cast(bf16x8, pw); }
#pragma unroll
    for (int s4 = 0; s4 < 4; s4 += 2) { bf16x8 vfv[2][8];
#pragma unroll
        for (int k2 = 0; k2 < 2; ++k2)
#pragma unroll
            for (int et = 0; et < 8; ++et) vfv[k2][et] = *(const LAS bf16x8*)(Vt + (16 * et + fr) * 272 + (32 * (s4 + k2) + 8 * fq) * 2);
        __builtin_amdgcn_sched_barrier(0);
#pragma unroll
        for (int k2 = 0; k2 < 2; ++k2)
#pragma unroll
            for (int et = 0; et < 8; ++et) Y[et] = MFMA16(vfv[k2][et], P[s4 + k2], Y[et]);
        __builtin_amdgcn_sched_barrier(0); }
    float sum = 0.f;
#pragma unroll
    for (int et = 0; et < 8; ++et) sum += (Y[et].x + Y[et].y) + (Y[et].z + Y[et].w);
    sum += __shfl_xor(sum, 16); sum += __shfl_xor(sum, 32);
    const float mu = sum * (1.f / HD); float var = 0.f;
#pragma unroll
    for (int et = 0; et < 8; ++et) { Y[et] = Y[et] - mu; var += (Y[et].x * Y[et].x + Y[et].y * Y[et].y) + (Y[et].z * Y[et].z + Y[et].w * Y[et].w); }
    var += __shfl_xor(var, 16); var += __shfl_xor(var, 32);
    const float rstd = 1.f / sqrtf(var * (1.f / HD) + EPS);
    const float* gn = F.a->in[I_GNG] + (size_t)(l * 8 + h) * HD + 4 * fq;
    bf16* op = FW(bf16, WS_MIX) + (size_t)(row0 + i) * DM + 1024 + h * 128 + 4 * fq;
    v2u gwv[8]; f32x4 ggv[8];
#pragma unroll
    for (int et = 0; et < 8; ++et) { gwv[et] = *(const GAS v2u*)(qp + C_GR + h * 128 + 16 * et + 4 * fq); ggv[et] = *(const GAS f32x4*)(gn + 16 * et); }
#pragma unroll
    for (int et = 0; et < 8; ++et) { const v2u gw = gwv[et]; const f32x4 gg = ggv[et];
        const float g0 = bflo(gw.x), g1 = bfhi(gw.x), g2 = bflo(gw.y), g3 = bfhi(gw.y);
        const float o0 = g0 * __builtin_amdgcn_rcpf(1.f + ex2(-1.44269504089f * g0)) * (Y[et].x * rstd * gg.x), o1 = g1 * __builtin_amdgcn_rcpf(1.f + ex2(-1.44269504089f * g1)) * (Y[et].y * rstd * gg.y);
        const float o2 = g2 * __builtin_amdgcn_rcpf(1.f + ex2(-1.44269504089f * g2)) * (Y[et].z * rstd * gg.z), o3 = g3 * __builtin_amdgcn_rcpf(1.f + ex2(-1.44269504089f * g3)) * (Y[et].w * rstd * gg.w);
        v2u wv; wv.x = pk2(o0, o1); wv.y = pk2(o2, o3); *(GAS v2u*)(op + 16 * et) = wv; }
    __syncthreads();
    if (nxt >= 0) ret_st_pair(Kn, Vt, F.tid, R);
    __syncthreads();
}
DI void ret_ctx_item(const Frame& F0, int l, int it) { const Frame F = launder(F0);
    LAS unsigned char* Kn = F.lds; LAS unsigned char* Vt = F.lds + 34816; LAS unsigned char* Sf = F.lds + 2 * 34816; LAS unsigned char* Sb = F.lds + 3 * 34816;
    const int cz = it >> 3, h = it & 7; v4u R[8];
    const bf16* zero = FW(bf16, WS_CTL + 512 * 1024);
    const bf16* sf = cz == 128 ? zero : FW(bf16, WS_KV) + (size_t)128 * 262144 + (size_t)(h * 2) * 16384;
    const bf16* sb = cz == 129 ? zero : FW(bf16, WS_KV) + (size_t)129 * 262144 + (size_t)(h * 2 + 1) * 16384;
    ret_ld_pair(sf, 128, sb, 128, F.tid, R); ret_st_pair(Sf, Sb, F.tid, R); ret_ld_kv(F, it, R); ret_st_pair(Kn, Vt, F.tid, R);
    __syncthreads();
    ret_item(F0, l, it, -1, R);
    __syncthreads();
}
DI void ph_attn_scan(const Frame& F0, int l) { const Frame F = launder(F0);
    LAS float* scf = (LAS float*)(F.lds + SCR_OFF);
    if (F.wave == 0) { const float* qg = F.a->in[I_QG] + l * HD; const float* kg = F.a->in[I_KG] + l * HD;
        float a = fmaxf(fabsf(qg[F.lane]), fabsf(qg[F.lane + 64])), b = fmaxf(fabsf(kg[F.lane]), fabsf(kg[F.lane + 64]));
        float s = F.lane < 8 ? F.a->in[I_SINK][l * 8 + F.lane] : -3.0e38f;
#pragma unroll
        for (int o = 1; o < 64; o <<= 1) { a = fmaxf(a, __shfl_xor(a, o)); b = fmaxf(b, __shfl_xor(b, o)); s = fmaxf(s, __shfl_xor(s, o)); }
        if (F.lane == 0) scf[0] = fmaxf(11.313708499f * a * b * 1.03f, s) * 1.44269504089f; }
    __syncthreads();
    const float m2 = scf[0];
    const int NX = (l == 0 && F.G >= 64) ? 24 : 0;
    const bool scans = F.bx >= NX, scan_first = ((F.bx >> 3) & 1) == 0;
    if (scans && scan_first) scan_share(F0, l, F.bx - NX, F.G - NX);
    const int NA = 512 + (l == 0 ? 8 : 0);
    for (int it = F.bx; it < NA; it += F.G) { const int b = it < 512 ? (it >> 2) : 128 + ((it - 512) >> 2), kvh = (it >> 1) & 1, pair = it & 1; attn_item(F, l, b, kvh, pair, m2); }
    __syncthreads();
    if (NX) { if (F.bx >= 8 && F.bx < 24) ret_ctx_item(F0, l, 1024 + F.bx - 8); }
    if (scans && !scan_first) scan_share(F0, l, F.bx - NX, F.G - NX);
}
DI void ph_retout(const Frame& F0, int l) { const Frame F = launder(F0);
    const int NI = (l == 0 && F.G < 64 ? NBLK : 128) * 8;
    LAS unsigned char* Kn = F.lds; LAS unsigned char* Vt = F.lds + 34816; LAS unsigned char* Sf = F.lds + 2 * 34816; LAS unsigned char* Sb = F.lds + 3 * 34816;
    v4u R[8];
    int it = F.bx;
    if (it < NI) { ret_ld_state(F, it, R); ret_st_pair(Sf, Sb, F.tid, R); ret_ld_kv(F, it, R); ret_st_pair(Kn, Vt, F.tid, R); }
    __syncthreads();
    for (; it < NI; it += F.G) ret_item(F0, l, it, it + F.G < NI ? it + F.G : -1, R);
}

DI void ph_gather(const Frame& F0) { const Frame F = launder(F0);
    LAS int* sc = (LAS int*)(F.lds + SCR_OFF);
    const int* RBCNT = (const int*)(F.a->ws + WS_RBCNT); const v4u* SEL = (const v4u*)(F.a->ws + WS_SEL); int* TOKSLOT = (int*)(F.a->ws + WS_TOKSLOT); int* PTAB = (int*)(F.a->ws + WS_PTAB);
    int* SLOTTOK = (int*)(F.a->ws + WS_SLOTTOK); float* SLOTG = (float*)(F.a->ws + WS_SLOTG);
    const int ge = F.tid & 7, gk = F.tid >> 3; int rc[4];
#pragma unroll
    for (int m = 0; m < 4; ++m) rc[m] = RBCNT[(gk + 64 * m) * 8 + ge];
    { int t = (rc[0] + rc[1]) + (rc[2] + rc[3]); t += __shfl_xor(t, 8); t += __shfl_xor(t, 16); t += __shfl_xor(t, 32); if (F.lane < 8) sc[32 + F.wave * 8 + F.lane] = t; }
    __syncthreads();
    if (F.tid < 8) { int t = 0; for (int w = 0; w < NWAVES; ++w) t += sc[32 + w * 8 + F.tid]; sc[F.tid] = t; }
    __syncthreads();
    if (F.tid == 0) { int r0 = 0, p = 0; for (int e = 0; e < 8; ++e) { sc[8 + e] = r0; const int np = (sc[e] + 255) >> 8; if (F.bx == 0) { PTAB[1 + PMAX + e] = p; for (int k = 0; k < np; ++k) PTAB[1 + p + k] = e; } p += np; r0 += np * 256; }
        if (F.bx == 0) { PTAB[0] = p; PTAB[1 + PMAX + 8] = p; } }
    __syncthreads();
    if (F.bx < 8) { const int e = F.bx, lo = sc[8 + e] + sc[e], hi = sc[8 + e] + (((sc[e] + 255) >> 8) << 8); for (int s = lo + F.tid; s < hi; s += NTHR) { SLOTTOK[s] = -1; SLOTG[s] = 0.f; } }
    for (int rb = F.bx; rb < 256; rb += F.G) {
        { int t = 0;
#pragma unroll
          for (int m = 0; m < 4; ++m) t += (gk + 64 * m) < rb ? rc[m] : 0;
          t += __shfl_xor(t, 8); t += __shfl_xor(t, 16); t += __shfl_xor(t, 32); if (F.lane < 8) sc[96 + F.wave * 8 + F.lane] = t; }
        __syncthreads();
        if (F.tid < 8) { int b = sc[8 + F.tid]; for (int w = 0; w < NWAVES; ++w) b += sc[96 + w * 8 + F.tid]; sc[16 + F.tid] = b; sc[24 + F.tid] = 0; }
        __syncthreads();
        if (F.tid < 128) { const int t = rb * 64 + (F.tid >> 1), p = F.tid & 1; const v4u sv = SEL[t];
            const int e = p ? (int)((sv.x >> 8) & 0xffu) : (int)(sv.x & 0xffu); const int pos = __hip_atomic_fetch_add(sc + 24 + e, 1, __ATOMIC_RELAXED, __HIP_MEMORY_SCOPE_WORKGROUP);
            const int slot = sc[16 + e] + pos; TOKSLOT[t * 2 + p] = slot; SLOTTOK[slot] = t; SLOTG[slot] = __uint_as_float(p ? sv.z : sv.y); }
        __syncthreads();
    }
}
DI void load_ptab(const Frame& F0) { const Frame F = launder(F0); LAS int* tab = (LAS int*)(F.lds + SCR_OFF); const int* PTAB = (const int*)(F.a->ws + WS_PTAB); for (int i = F.tid; i < 1 + PMAX; i += NTHR) tab[i] = PTAB[i];
    if (F.tid < 24) tab[176 + F.tid] = (int)((const unsigned*)(F.a->ws + WS_CTL))[CW_AMAX + F.tid];
    if (F.tid >= 32 && F.tid < 41) tab[160 + F.tid - 32] = PTAB[1 + PMAX + F.tid - 32];
    __syncthreads(); }

DI void ph_combine(const Frame& F0) { const Frame F = launder(F0);
    const v4u* SEL = (const v4u*)(F.a->ws + WS_SEL); const int* TOKSLOT = (const int*)(F.a->ws + WS_TOKSLOT);
    const float* gate = FW(float, WS_MODS) + 24576 + 5 * 2048;
    const int gw = F.bx * NWAVES + F.wave, NGW = F.G * NWAVES;
    const int P = ((const int*)(F.a->ws + WS_PTAB))[0]; const int full = ((8 * P) / F.G) * F.G;
    const int T = 8 * P - full, sp = pg8::tail_splits(T, F.G), tcap = sp ? F.G / sp : 0;
    const float* PT = FW(float, WS_PT);
    LAS int* tl = (LAS int*)F.lds;
    for (int i = F.tid; i < P * 8; i += NTHR) tl[i] = pg8::moe_index(i >> 3, i & 7, P, 8) - full;
    __syncthreads();
    f32x4 gt[8];
#pragma unroll
    for (int j = 0; j < 8; ++j) gt[j] = *(const f32x4*)(gate + 4 * F.lane + 256 * j);
    for (int t0 = gw; t0 < SEQ; t0 += 2 * NGW) {
        int tk[2], sl[2][2]; float gg[2][2]; v2u xv[2][8], ya[2][8], yb[2][8];
#pragma unroll
        for (int u = 0; u < 2; ++u) { tk[u] = t0 + u * NGW < SEQ ? t0 + u * NGW : t0; const v4u sv = SEL[tk[u]]; gg[u][0] = __uint_as_float(sv.y); gg[u][1] = __uint_as_float(sv.z);
            sl[u][0] = TOKSLOT[tk[u] * 2]; sl[u][1] = TOKSLOT[tk[u] * 2 + 1]; }
#pragma unroll
        for (int u = 0; u < 2; ++u) {
            const GAS v2u* xb = (const GAS v2u*)(FW(bf16, WS_XB) + (size_t)tk[u] * DM) + F.lane;
            const GAS v2u* y0 = (const GAS v2u*)(FW(bf16, WS_YP) + (size_t)sl[u][0] * DM) + F.lane; const GAS v2u* y1 = (const GAS v2u*)(FW(bf16, WS_YP) + (size_t)sl[u][1] * DM) + F.lane;
#pragma unroll
            for (int j = 0; j < 8; ++j) { xv[u][j] = xb[64 * j]; ya[u][j] = y0[64 * j]; yb[u][j] = y1[64 * j]; } }
#pragma unroll
        for (int u = 0; u < 2; ++u) {
            if (u == 1 && t0 + NGW >= SEQ) break;
            GAS f32x4* xo = (GAS f32x4*)(F.a->out + (size_t)tk[u] * DM) + F.lane;
            const LAS int* tp0 = tl + (sl[u][0] >> 8) * 8; const LAS int* tp1 = tl + (sl[u][1] >> 8) * 8;
#pragma unroll
            for (int j = 0; j < 8; ++j) {
                f32x4 a = (f32x4){bflo(ya[u][j].x), bfhi(ya[u][j].x), bflo(ya[u][j].y), bfhi(ya[u][j].y)}, b = (f32x4){bflo(yb[u][j].x), bfhi(yb[u][j].x), bflo(yb[u][j].y), bfhi(yb[u][j].y)};
                if (sp) {
                    const int i0 = tp0[j], i1 = tp1[j];
                    if (i0 >= 0) { a = (f32x4){0.f, 0.f, 0.f, 0.f};
#pragma unroll
                        for (int q = 0; q < 6; ++q) { const int qs = q < sp ? q : 0; const f32x4 v = *(const GAS f32x4*)(PT + ((size_t)(qs * tcap + i0) * 256 + (sl[u][0] & 255)) * 256 + 4 * F.lane); a += q < sp ? v : (f32x4){0.f, 0.f, 0.f, 0.f}; } }
                    if (i1 >= 0) { b = (f32x4){0.f, 0.f, 0.f, 0.f};
#pragma unroll
                        for (int q = 0; q < 6; ++q) { const int qs = q < sp ? q : 0; const f32x4 v = *(const GAS f32x4*)(PT + ((size_t)(qs * tcap + i1) * 256 + (sl[u][1] & 255)) * 256 + 4 * F.lane); b += q < sp ? v : (f32x4){0.f, 0.f, 0.f, 0.f}; } } }
                const f32x4 x = (f32x4){bflo(xv[u][j].x), bfhi(xv[u][j].x), bflo(xv[u][j].y), bfhi(xv[u][j].y)};
                xo[64 * j] = x + gt[j] * (gg[u][0] * a + gg[u][1] * b); } }
    }
}

#ifndef PG8_SP2
#define PG8_SP2 true
#endif
#ifndef PG8_ALIGN
#define PG8_ALIGN true
#endif
#ifndef MK_MULTI
#define MK_MULTI 0
#endif
constexpr int NPHASE = 26;
#ifndef PHASE_MASK
#define PHASE_MASK 0xffffffffu
#endif
#define PHM(j) ((PHASE_MASK >> (j)) & 1u)
#define IN(k) (lo <= (k) && (k) < hi)
#ifndef DUP_PHASE
#define DUP_PHASE (-1)
#define DUP_N 1
#endif
#define NREP(k) (((k) == DUP_PHASE) ? DUP_N : 1)
#define SEAM(k) do { if ((lo <= (k) && (k) + 1 < hi) || rep_ + 1 < NREP(k)) xcd_barrier(bar); } while (0)

#ifndef CVQ_IN
#define CVQ_IN 16
#define CVQ_FF 8
#endif
constexpr int CV_NIN = 106 * NWAVES * CVQ_IN, CV_NFF = 212 * NWAVES * CVQ_FF, CV0 = CVT_NMOE - 2 * CV_NIN - CV_NFF;
static_assert(CV0 > 0, "quota");
template <int l> DI void layer_body(const Frame& F0, const XcdBarrier& bar, const int lo, const int hi) {

        const int pb = 2 + 12 * l;
        const int MR = (l == 0) ? NROW : SEQ;
        if (PHM(2) && IN(pb + 0)) for (int rep_ = 0; rep_ < NREP(pb + 0); ++rep_) { ph_norm(F0, l, 0, NROW / 64, false); SEAM(pb + 0); }
        if (PHM(3) && IN(pb + 1)) for (int rep_ = 0; rep_ < NREP(pb + 1); ++rep_) {
            const Frame F = launder(F0); pg8::Gemm g{FW(bf16, WS_H), FW(bf16, WS_WIN) + (size_t)l * INC * DM, NROW, INC, DM, DM}; pg8::StaticOrder S; S.init(NROW, INC, F.G, F.bx);
            pg8::EpiStoreBf16 E{FW(bf16, WS_PROJ), INC, 1 << 30};
            pg8::gemm_phase<pg8::EpiStoreBf16, pg8::StaticOrder, PG8_ALIGN, PG8_SP2>(F.lds, g, S, E);
            if (F.G == 256 && F.bx >= 150) { const int lo = l == 0 ? CV0 : CV0 + CV_NIN + CV_NFF; cvt_moe_range(F0, lo, lo + CV_NIN, (F.bx - 150) * NWAVES + F.wave, 106 * NWAVES); }
            SEAM(pb + 1);
        }
        if (PHM(4) && IN(pb + 2)) for (int rep_ = 0; rep_ < NREP(pb + 2); ++rep_) { ph_prep_kv(F0, l); SEAM(pb + 2); }
        if (PHM(5) && IN(pb + 3)) for (int rep_ = 0; rep_ < NREP(pb + 3); ++rep_) { ph_attn_scan(F0, l); SEAM(pb + 3); }
        if (PHM(7) && IN(pb + 5)) for (int rep_ = 0; rep_ < NREP(pb + 5); ++rep_) { ph_retout(F0, l); SEAM(pb + 5); }
        if (PHM(8) && IN(pb + 6)) for (int rep_ = 0; rep_ < NREP(pb + 6); ++rep_) {
            const Frame F = launder(F0); pg8::Gemm g{FW(bf16, WS_MIX), FW(bf16, WS_WOUT) + (size_t)l * DM * DM, SEQ, DM, DM, DM}; pg8::StaticOrder S; S.init(SEQ, DM, F.G, F.bx);
            const float* md = FW(float, WS_MODS) + (size_t)l * 24576;
            pg8::EpiResidB<l == 0> E{F.a->in[I_X], FW(bf16, WS_XB), md + 2 * 2048, DM};
            pg8::gemm_phase<pg8::EpiResidB<l == 0>, pg8::StaticOrder, PG8_ALIGN, PG8_SP2>(F.lds, g, S, E);
            if constexpr (l == 0) {
                const Frame F = launder(F0);
                pg8::Gemm g2{FW(bf16, WS_MIX), FW(bf16, WS_WOUT), NROW, DM, 256, DM}; pg8::SplitOrder S2{64, 8, 8, 256, F.G, F.bx};
                pg8::EpiPartial E2{FW(float, WS_PC1), 256, DM};
                pg8::gemm_phase<pg8::EpiPartial, pg8::SplitOrder, PG8_ALIGN, PG8_SP2>(F.lds, g2, S2, E2);
            }
            SEAM(pb + 6);
        }
        if (PHM(2) && IN(pb + 7)) for (int rep_ = 0; rep_ < NREP(pb + 7); ++rep_) { ph_norm(F0, l, 1, MR / 64, l == 1); SEAM(pb + 7); }
        if constexpr (l == 0) {
            if (PHM(9) && IN(pb + 8)) for (int rep_ = 0; rep_ < NREP(pb + 8); ++rep_) {
                const Frame F = launder(F0); pg8::Gemm g{FW(bf16, WS_H), FW(bf16, WS_WF13), NROW, 2 * DFF, DM, DM}; pg8::StaticOrder S; S.init(NROW, 2 * DFF, F.G, F.bx);
                pg8::EpiSwiglu E{FW(bf16, WS_U), DFF, 1 << 30};
                pg8::gemm_phase<pg8::EpiSwiglu, pg8::StaticOrder, PG8_ALIGN, PG8_SP2>(F.lds, g, S, E);
                if (F.G == 256 && F.bx >= 44) cvt_moe_range(F0, CV0 + CV_NIN, CV0 + CV_NIN + CV_NFF, (F.bx - 44) * NWAVES + F.wave, 212 * NWAVES);
                SEAM(pb + 8);
            }
            if (PHM(10) && IN(pb + 9)) for (int rep_ = 0; rep_ < NREP(pb + 9); ++rep_) {
                const Frame F = launder(F0); pg8::Gemm g{FW(bf16, WS_U), FW(bf16, WS_WF2), SEQ, DM, DFF, DFF}; pg8::StaticOrder S; S.init(SEQ, DM, F.G, F.bx);
                const float* md = FW(float, WS_MODS);
                pg8::EpiResidB<false> E{nullptr, FW(bf16, WS_XB), md + 5 * 2048, DM};
                pg8::gemm_phase<pg8::EpiResidB<false>, pg8::StaticOrder, PG8_ALIGN, PG8_SP2>(F.lds, g, S, E);
                { const Frame F = launder(F0); pg8::Gemm g2{FW(bf16, WS_U), FW(bf16, WS_WF2), NROW, DM, 512, DFF}; pg8::SplitOrder S2{64, 8, 11, 512, F.G, F.bx};
                  pg8::EpiPartial E2{FW(float, WS_PC2), 512, DM};
                  pg8::gemm_phase<pg8::EpiPartial, pg8::SplitOrder, PG8_ALIGN, PG8_SP2>(F.lds, g2, S2, E2); }
                SEAM(pb + 9);
            }
        } else {
            if (PHM(11) && IN(pb + 8)) for (int rep_ = 0; rep_ < NREP(pb + 8); ++rep_) { ph_gather(F0); SEAM(pb + 8); }
            if (PHM(12) && IN(pb + 9)) for (int rep_ = 0; rep_ < NREP(pb + 9); ++rep_) {
                load_ptab(F0);
                const Frame F = launder(F0); pg8::Gemm g{FW(bf16, WS_H), FW(bf16, WS_WM13), PMAX * 256, 2 * DFF, DM / 2, DM / 2}; pg8::MoeOrderE S{(const LAS int*)(F.lds + SCR_OFF), 2 * DFF / 256, F.G, F.bx, (const int*)(F.a->ws + WS_SLOTTOK)};
                pg8::EpiSwiglu8 E{FW(unsigned char, WS_U), DFF, 2 * DFF / 256, (const LAS unsigned*)(F.lds + SCR_OFF) + 176, F8_SH, F8_SU};
                pg8::gemm_phase<pg8::EpiSwiglu8, pg8::MoeOrderE, PG8_ALIGN, PG8_SP2, true>(F.lds, g, S, E);
                SEAM(pb + 9);
            }
            if (PHM(13) && IN(pb + 10)) for (int rep_ = 0; rep_ < NREP(pb + 10); ++rep_) {
                load_ptab(F0);
                const Frame F = launder(F0); pg8::Gemm g{FW(bf16, WS_U), FW(bf16, WS_WM2), PMAX * 256, DM, DFF / 2, DFF / 2}; pg8::MoeOrder S{(const LAS int*)(F.lds + SCR_OFF), DM / 256, F.G, F.bx, 1};
                pg8::EpiStoreBf16S E{FW(bf16, WS_YP), DM, DM / 256, (const LAS unsigned*)(F.lds + SCR_OFF) + 176, F8_SU};
                pg8::gemm_phase<pg8::EpiStoreBf16S, pg8::MoeOrder, PG8_ALIGN, PG8_SP2, true>(F.lds, g, S, E);
                { const Frame F = launder(F0); pg8::MoeTailOrder S2{(const LAS int*)(F.lds + SCR_OFF), DM / 256, F.G, F.bx, DFF / 256}; const int sp = S2.splits();
                  if (sp) { pg8::Gemm g2{FW(bf16, WS_U), FW(bf16, WS_WM2), PMAX * 256, DM, DFF / 2, DFF / 2}; const int P = S2.tab[0];
                    pg8::EpiTailPartial E2{FW(float, WS_PT), P, DM / 256, ((8 * P) / F.G) * F.G, F.G / sp, (const LAS unsigned*)(F.lds + SCR_OFF) + 176, F8_SU};
                    pg8::gemm_phase<pg8::EpiTailPartial, pg8::MoeTailOrder, PG8_ALIGN, PG8_SP2, true>(F.lds, g2, S2, E2); } }
                SEAM(pb + 10);
            }
            if (PHM(14) && IN(pb + 11)) { ph_combine(F0); }
        }
    }
__global__ void __launch_bounds__(NTHR, 2) fwd_kernel(Args args) {
    extern __shared__ __attribute__((aligned(16))) unsigned char lds[];
    Frame F0;
    F0.lds = (LAS unsigned char*)lds;
    F0.tid = threadIdx.x; F0.lane = F0.tid & 63; F0.wave = __builtin_amdgcn_readfirstlane(F0.tid >> 6); F0.G = gridDim.x; F0.bx = blockIdx.x;
    F0.a = (const __attribute__((address_space(4))) Args*)__builtin_amdgcn_kernarg_segment_ptr();
    unsigned char* ws = args.ws;
    volatile LAS unsigned* MISC = (volatile LAS unsigned*)(F0.lds + MISC_OFF);
    for (int u = F0.tid; u < (LDS_BYTES - MISC_OFF) / 4; u += NTHR) ((LAS unsigned*)(F0.lds + MISC_OFF))[u] = 0u;
    __syncthreads();
    const int lo = args.ph_lo, hi = args.ph_hi;
    XcdBarrier bar; bar.bar = (unsigned*)(ws + WS_CTL) + CW_BAR; bar.x = 0; bar.st = MISC + 8;
    if (hi - lo > 1) bar = xcd_barrier_post((unsigned*)(ws + WS_CTL) + CW_BAR, MISC + 8);
    if (PHM(0) && IN(0)) for (int rep_ = 0; rep_ < NREP(0); ++rep_) { ph_ada(F0); SEAM(0); }
    if (PHM(1) && IN(1)) for (int rep_ = 0; rep_ < NREP(1); ++rep_) { ph_cvt(F0, F0.G == 256 ? CV0 : CVT_NMOE); SEAM(1); }
    layer_body<0>(F0, bar, lo, hi);
    layer_body<1>(F0, bar, lo, hi);
#undef IN
#undef SEAM
}

extern "C" void kernel_launch(void* const* d_in, const int* in_sizes, int n_in, void* d_out, int out_size, void* d_ws, size_t ws_size, hipStream_t stream) {
    static int grid = 0;
    if (grid == 0) {
        if (n_in != 23 || out_size != SEQ * DM || ws_size < WS_END) { fprintf(stderr, "kernel_launch: unexpected shapes (n_in %d, out %d, ws %zu); nothing launched\n", n_in, out_size, ws_size); grid = -1; return; }
        int dev = 0, cus = 0, per_cu = 0;
        if (hipGetDevice(&dev) != hipSuccess || hipDeviceGetAttribute(&cus, hipDeviceAttributeMultiprocessorCount, dev) != hipSuccess) { grid = -1; return; }
        if (hipFuncSetAttribute((const void*)fwd_kernel, hipFuncAttributeMaxDynamicSharedMemorySize, LDS_BYTES) != hipSuccess) { fprintf(stderr, "kernel_launch: hipFuncSetAttribute failed\n"); grid = -1; return; }
        if (hipOccupancyMaxActiveBlocksPerMultiprocessor(&per_cu, (const void*)fwd_kernel, NTHR, LDS_BYTES) != hipSuccess || per_cu < 1) { fprintf(stderr, "kernel_launch: occupancy query says %d blocks per CU\n", per_cu); }
        (void)hipGetLastError();
        grid = cus;
    }
    if (grid < 0) return;
    (void)hipMemsetAsync((char*)d_ws + WS_CTL, 0, CTL_ZERO_BYTES, stream);
    Args a{};
    for (int i = 0; i < 23; ++i) a.in[i] = (const float*)d_in[i];
    a.out = (float*)d_out; a.ws = (unsigned char*)d_ws;
#if MK_MULTI
    for (int p = 0; p < NPHASE; ++p) { if (p == 2 + 4 || p == 2 + 10 || p == 2 + 11 || p == 14 + 4) continue; a.ph_lo = p; a.ph_hi = p + 1; hipLaunchKernelGGL(fwd_kernel, dim3(grid), dim3(NTHR), LDS_BYTES, stream, a); }
#else
    a.ph_lo = 0; a.ph_hi = NPHASE;
    hipLaunchKernelGGL(fwd_kernel, dim3(grid), dim3(NTHR), LDS_BYTES, stream, a);
#endif
    (void)in_sizes;
}
```
